# Optimizing an MI355X kernel written in HIP

```python
import jax, jax.numpy as jnp
from jax import lax
import numpy as np

D_MODEL = 1024
BATCH = 8
SEQ = 4096
DEPTH = 4

N_EVEN = (DEPTH + 1) // 2
N_ODD = DEPTH // 2
D_PLE = 256
D_FF = 4 * D_MODEL
DN_ALPHA = (2.0 * DEPTH) ** 0.25
DN_BETA = (8.0 * DEPTH) ** -0.25
LN_EPS = 1e-5
NEG = -1e30

A_HEADS = 4
A_DH = D_MODEL // 8
A_W = A_HEADS * A_DH
A_CONV = 4
A_CHUNK = 64

B_HEADS = 8
B_DH = 64
B_W = B_HEADS * B_DH
B_KV = 2
B_HPG = B_HEADS // B_KV
B_KVW = B_KV * B_DH
B_CMP_LEN = 32
B_CMP_STRIDE = 16
B_CMP_HID = 128
B_SEL_BLK = 64
B_SEL_N = 16
B_WIN = 512
B_QBLK = 64

C_HEADS = 8
C_DN = 128
C_DR = 64
C_DV = 128
C_QL = 512
C_KVL = 256
C_IDX_HEADS = 8
C_IDX_DH = 64
C_IDX_DR = 32
C_TOPK = 256
C_QBLK = 128
ROPE_BASE = 10000.0

EVEN_SIZES = (A_W, A_W, A_W, A_W, A_HEADS, A_HEADS, B_W, B_KVW, B_KVW, B_KVW, B_KVW, B_KVW, B_KVW, 3 * B_HEADS)
ODD_SIZES = (C_QL, C_KVL, C_DR, C_IDX_DH, C_IDX_HEADS)

kernel_name = 'hybrid_mlstm_nsa_dsa_deepnorm'


def _split(z, sizes):
    out, o = [], 0
    for s in sizes:
        out.append(z[..., o:o + s])
        o += s
    return out


def _layer_norm(x, g, b):
    xf = x.astype(jnp.float32)
    mu = xf.mean(-1, keepdims=True)
    var = jnp.square(xf - mu).mean(-1, keepdims=True)
    return ((xf - mu) * lax.rsqrt(var + LN_EPS) * g + b).astype(x.dtype)


def _rms_norm(x, g):
    xf = x.astype(jnp.float32)
    return (xf * lax.rsqrt(jnp.square(xf).mean(-1, keepdims=True) + LN_EPS) * g).astype(x.dtype)


def _masked_softmax(s, mask):
    s = jnp.where(mask, s.astype(jnp.float32), NEG)
    return jnp.where(mask, jax.nn.softmax(s, axis=-1), 0.0)


def _causal_dwconv(x, w):
    k = w.shape[0]
    return lax.conv_general_dilated(x, w[:, None, :].astype(x.dtype), window_strides=(1,), padding=[(k - 1, 0)],
                                    dimension_numbers=('NWC', 'WIO', 'NWC'), feature_group_count=x.shape[-1])


def _rope_tables(pos, d):
    inv = ROPE_BASE ** (-jnp.arange(0, d, 2, dtype=jnp.float32) / d)
    ang = pos.astype(jnp.float32)[..., None] * inv
    return jnp.cos(ang), jnp.sin(ang)


def _rope(x, cos, sin):
    h = x.shape[-1] // 2
    c, s = cos.astype(x.dtype), sin.astype(x.dtype)
    x1, x2 = x[..., :h], x[..., h:]
    return jnp.concatenate([x1 * c - x2 * s, x1 * s + x2 * c], -1)


def _mlstm(q, k, v, o, ig, fg, conv_w, norm_g):
    B, T, _ = q.shape
    dt = q.dtype
    qk = jax.nn.silu(_causal_dwconv(jnp.concatenate([q, k], -1), conv_w))
    q, k = qk[..., :A_W], qk[..., A_W:]
    N = T // A_CHUNK

    def heads(u):
        return u.astype(jnp.float32).reshape(B, N, A_CHUNK, A_HEADS, A_DH).transpose(1, 0, 3, 2, 4)

    def gate(u):
        return u.astype(jnp.float32).reshape(B, N, A_CHUNK, A_HEADS).transpose(1, 0, 3, 2)

    xs = (heads(q) * A_DH ** -0.5, heads(k), heads(v), gate(ig), jax.nn.log_sigmoid(gate(fg)))
    causal = jnp.tril(jnp.ones((A_CHUNK, A_CHUNK), bool))

    def step(carry, inp):
        C, n, m = carry
        qc, kc, vc, ic, lf = inp
        b = jnp.cumsum(lf, axis=-1)
        D = jnp.where(causal, b[..., :, None] - b[..., None, :] + ic[..., None, :], NEG)
        m_inter = b + m[..., None]
        m_t = jnp.maximum(m_inter, D.max(-1))
        e_inter = jnp.exp(m_inter - m_t)
        S = jnp.einsum('bhld,bhsd->bhls', qc, kc) * jnp.exp(D - m_t[..., None])
        num = e_inter[..., None] * jnp.einsum('bhld,bhvd->bhlv', qc, C) + jnp.einsum('bhls,bhsv->bhlv', S, vc)
        den = e_inter * jnp.einsum('bhld,bhd->bhl', qc, n) + S.sum(-1)
        hc = num / jnp.maximum(jnp.abs(den), jnp.exp(-m_t))[..., None]
        bL = b[..., -1]
        dec = bL[..., None] - b + ic
        m_new = jnp.maximum(bL + m, dec.max(-1))
        w = jnp.exp(dec - m_new[..., None])
        e_st = jnp.exp(bL + m - m_new)
        C_new = e_st[..., None, None] * C + jnp.einsum('bhs,bhsv,bhsd->bhvd', w, vc, kc)
        n_new = e_st[..., None] * n + jnp.einsum('bhs,bhsd->bhd', w, kc)
        return (C_new, n_new, m_new), hc

    init = (jnp.zeros((B, A_HEADS, A_DH, A_DH), jnp.float32), jnp.zeros((B, A_HEADS, A_DH), jnp.float32),
            jnp.zeros((B, A_HEADS), jnp.float32))
    _, hs = lax.scan(step, init, xs)
    hs = hs.transpose(1, 0, 3, 2, 4).reshape(B, T, A_HEADS, A_DH)
    mu = hs.mean(-1, keepdims=True)
    var = jnp.square(hs - mu).mean(-1, keepdims=True)
    hn = ((hs - mu) * lax.rsqrt(var + LN_EPS)).reshape(B, T, A_W) * norm_g
    return (hn * jax.nn.sigmoid(o.astype(jnp.float32))).astype(dt)


def _nsa(q, kc_raw, vc_raw, ks, vs, kw, vw, g_pre, cmp_pos, cmp_w1, cmp_w2):
    B, T, _ = q.shape
    dt = q.dtype
    q = q.reshape(B, T, B_KV, B_HPG, B_DH) * B_DH ** -0.5
    r = lambda u: u.reshape(B, T, B_KV, B_DH)
    M = (T - B_CMP_LEN) // B_CMP_STRIDE + 1
    NSB = T // B_SEL_BLK
    n_sel = min(B_SEL_N, NSB)
    win = jnp.arange(M)[:, None] * B_CMP_STRIDE + jnp.arange(B_CMP_LEN)[None, :]

    def compress(u, j):
        blk = u[:, win] + cmp_pos[j][None, None, :, None, :].astype(dt)
        blk = blk.transpose(0, 1, 3, 2, 4).reshape(B, M, B_KV, B_CMP_LEN * B_DH)
        return jax.nn.gelu(blk @ cmp_w1[j]) @ cmp_w2[j]

    k_cmp = compress(r(kc_raw), 0)
    v_cmp = compress(r(vc_raw), 1)
    cmp_end = jnp.arange(M) * B_CMP_STRIDE + B_CMP_LEN - 1
    mi, jb = jnp.arange(M), jnp.arange(NSB)
    overlap = ((mi[:, None] * B_CMP_STRIDE < (jb[None, :] + 1) * B_SEL_BLK) &
               (mi[:, None] * B_CMP_STRIDE + B_CMP_LEN > jb[None, :] * B_SEL_BLK)).astype(jnp.float32)
    ks_blk = r(ks).reshape(B, NSB, B_SEL_BLK, B_KV, B_DH).transpose(0, 3, 1, 2, 4)
    vs_blk = r(vs).reshape(B, NSB, B_SEL_BLK, B_KV, B_DH).transpose(0, 3, 1, 2, 4)
    kw_pad = jnp.pad(r(kw), ((0, 0), (B_WIN, 0), (0, 0), (0, 0)))
    vw_pad = jnp.pad(r(vw), ((0, 0), (B_WIN, 0), (0, 0), (0, 0)))
    gates = jax.nn.sigmoid(g_pre.astype(jnp.float32)).reshape(B, T, B_KV, B_HPG, 3)
    bi = jnp.arange(B)[:, None, None, None]
    gi = jnp.arange(B_KV)[None, :, None, None]
    wlen = B_WIN + B_QBLK

    def block(c):
        s0 = c * B_QBLK
        tq = s0 + jnp.arange(B_QBLK)
        qb = lax.dynamic_slice_in_dim(q, s0, B_QBLK, 1)
        s = jnp.einsum('bqghd,bmgd->bqghm', qb, k_cmp)
        p_cmp = _masked_softmax(s, (cmp_end[None, :] <= tq[:, None])[None, :, None, None, :])
        o_cmp = jnp.einsum('bqghm,bmgd->bqghd', p_cmp.astype(dt), v_cmp)
        imp = p_cmp.sum(3) @ overlap
        cur = tq[:, None] // B_SEL_BLK
        forced = (jb[None, :] == 0) | (jb[None, :] == cur) | (jb[None, :] == cur - 1)
        valid = jb[None, :] * B_SEL_BLK <= tq[:, None]
        score = jnp.where(forced[None, :, None, :], 1e6, imp)
        score = jnp.where(valid[None, :, None, :], score, NEG)
        _, idx = lax.top_k(score, n_sel)
        idx = idx.transpose(0, 2, 1, 3)
        k_sel = ks_blk[bi, gi, idx].reshape(B, B_KV, B_QBLK, n_sel * B_SEL_BLK, B_DH)
        v_sel = vs_blk[bi, gi, idx].reshape(B, B_KV, B_QBLK, n_sel * B_SEL_BLK, B_DH)
        kpos = (idx[..., None] * B_SEL_BLK + jnp.arange(B_SEL_BLK)).reshape(B, B_KV, B_QBLK, n_sel * B_SEL_BLK)
        s = jnp.einsum('bgqhd,bgqkd->bgqhk', qb.transpose(0, 2, 1, 3, 4), k_sel)
        p = _masked_softmax(s, (kpos <= tq[None, None, :, None])[:, :, :, None, :])
        o_sel = jnp.einsum('bgqhk,bgqkd->bqghd', p.astype(dt), v_sel)
        kwb = lax.dynamic_slice_in_dim(kw_pad, s0, wlen, 1)
        vwb = lax.dynamic_slice_in_dim(vw_pad, s0, wlen, 1)
        wpos = s0 - B_WIN + jnp.arange(wlen)
        wmask = (wpos[None, :] <= tq[:, None]) & (wpos[None, :] > tq[:, None] - B_WIN) & (wpos[None, :] >= 0)
        s = jnp.einsum('bqghd,bkgd->bqghk', qb, kwb)
        p = _masked_softmax(s, wmask[None, :, None, None, :])
        o_win = jnp.einsum('bqghk,bkgd->bqghd', p.astype(dt), vwb)
        gb = lax.dynamic_slice_in_dim(gates, s0, B_QBLK, 1).astype(dt)
        o = gb[..., 0:1] * o_cmp + gb[..., 1:2] * o_sel + gb[..., 2:3] * o_win
        return o.reshape(B, B_QBLK, B_W)

    out = lax.map(block, jnp.arange(T // B_QBLK))
    return out.transpose(1, 0, 2, 3).reshape(B, T, B_W)


def _even_mixer(h, w_in, a_conv, a_i_b, a_f_b, a_norm, b_cmp_pos, b_cmp_w1, b_cmp_w2, b_g_b, w_out):
    aq, ak, av, ao, ai, af, bq, bkc, bvc, bks, bvs, bkw, bvw, bg = _split(h @ w_in, EVEN_SIZES)
    ya = _mlstm(aq, ak, av, ao, ai + a_i_b, af + a_f_b, a_conv, a_norm)
    yb = _nsa(bq, bkc, bvc, bks, bvs, bkw, bvw, bg + b_g_b, b_cmp_pos, b_cmp_w1, b_cmp_w2)
    return jnp.concatenate([ya, yb], -1) @ w_out


def _odd_mixer(h, pos, w_in, q_norm, kv_norm, w_qb, w_uk, w_uv, w_iq, ik_g, ik_b, w_out):
    B, T, _ = h.shape
    dt = h.dtype
    cq, ckv, kr, ik, iw = _split(h @ w_in, ODD_SIZES)
    cq = _rms_norm(cq, q_norm)
    ckv = _rms_norm(ckv, kv_norm)
    cos, sin = _rope_tables(pos, C_DR)
    qf = (cq @ w_qb).reshape(B, T, C_HEADS, C_DN + C_DR)
    q_rope = _rope(qf[..., C_DN:], cos[:, :, None], sin[:, :, None])
    k_rope = _rope(kr, cos, sin)
    q_abs = jnp.einsum('bthd,chd->bthc', qf[..., :C_DN], w_uk)
    qa = jnp.concatenate([q_abs, q_rope], -1) * (C_DN + C_DR) ** -0.5
    kv_cat = jnp.concatenate([ckv, k_rope], -1)
    icos, isin = _rope_tables(pos, C_IDX_DR)
    qi = (cq @ w_iq).reshape(B, T, C_IDX_HEADS, C_IDX_DH)
    qi = jnp.concatenate([_rope(qi[..., :C_IDX_DR], icos[:, :, None], isin[:, :, None]), qi[..., C_IDX_DR:]], -1)
    ki = _layer_norm(ik, ik_g, ik_b)
    ki = jnp.concatenate([_rope(ki[..., :C_IDX_DR], icos, isin), ki[..., C_IDX_DR:]], -1)
    wi = iw * (C_IDX_HEADS ** -0.5 * C_IDX_DH ** -0.5)
    k_sel = min(C_TOPK, T // 4)
    kpos = jnp.arange(T)
    bidx = jnp.arange(B)[:, None, None]

    def block(c):
        s0 = c * C_QBLK
        tq = s0 + jnp.arange(C_QBLK)
        qib = lax.dynamic_slice_in_dim(qi, s0, C_QBLK, 1)
        wib = lax.dynamic_slice_in_dim(wi, s0, C_QBLK, 1)
        isc = jnp.einsum('bqh,bqhs->bqs', wib, jax.nn.relu(jnp.einsum('bqhd,bsd->bqhs', qib, ki))).astype(jnp.float32)
        isc = jnp.where(kpos[None, None, :] <= tq[None, :, None], isc, NEG)
        _, idx = lax.top_k(isc, k_sel)
        g = kv_cat[bidx, idx]
        qab = lax.dynamic_slice_in_dim(qa, s0, C_QBLK, 1)
        s = jnp.einsum('bqhc,bqkc->bqhk', qab, g)
        pr = _masked_softmax(s, (idx <= tq[None, :, None])[:, :, None, :])
        return jnp.einsum('bqhk,bqkc->bqhc', pr.astype(dt), g[..., :C_KVL])

    o_lat = lax.map(block, jnp.arange(T // C_QBLK))
    o_lat = o_lat.transpose(1, 0, 2, 3, 4).reshape(B, T, C_HEADS, C_KVL)
    o = jnp.einsum('bthc,chv->bthv', o_lat, w_uv).reshape(B, T, C_HEADS * C_DV)
    return o @ w_out


def setup_inputs(seed: int = 0) -> dict:
    key = jax.random.key(seed)
    keys = iter(jax.random.split(key, 64))

    def nrm(shape, scale):
        return jax.random.normal(next(keys), shape, jnp.float32) * scale

    E, O, L, D = N_EVEN, N_ODD, DEPTH, D_MODEL
    sD = D ** -0.5
    x = nrm((BATCH, SEQ, D), 1.0)
    p = nrm((DEPTH, BATCH, SEQ, D_PLE), 1.0)
    positions = jnp.broadcast_to(jnp.arange(SEQ, dtype=jnp.int32), (BATCH, SEQ))
    seg = lambda n, sc=1.0: nrm((E, D, n), sD * sc)
    e_w_in = jnp.concatenate([seg(A_W), seg(A_W), seg(A_W, DN_BETA), seg(A_W), seg(A_HEADS), seg(A_HEADS),
                              seg(B_W), seg(B_KVW), seg(B_KVW, DN_BETA), seg(B_KVW), seg(B_KVW, DN_BETA),
                              seg(B_KVW), seg(B_KVW, DN_BETA), seg(3 * B_HEADS)], axis=-1)
    e_a_conv = nrm((E, A_CONV, 2 * A_W), A_CONV ** -0.5)
    e_a_i_b = nrm((E, A_HEADS), 0.1)
    e_a_f_b = jnp.linspace(3.0, 6.0, A_HEADS, dtype=jnp.float32)[None] + nrm((E, A_HEADS), 0.1)
    e_a_norm = 1.0 + nrm((E, A_W), 0.02)
    e_b_cmp_pos = nrm((E, 2, B_CMP_LEN, B_DH), 0.1)
    e_b_cmp_w1 = nrm((E, 2, B_CMP_LEN * B_DH, B_CMP_HID), (B_CMP_LEN * B_DH) ** -0.5)
    e_b_cmp_w2 = nrm((E, 2, B_CMP_HID, B_DH), B_CMP_HID ** -0.5) * jnp.array([1.0, DN_BETA], jnp.float32)[None, :, None, None]
    e_b_g_b = nrm((E, 3 * B_HEADS), 0.1)
    e_w_out = nrm((E, A_W + B_W, D), (A_W + B_W) ** -0.5 * DN_BETA)
    o_w_in = jnp.concatenate([nrm((O, D, n), sD) for n in ODD_SIZES], axis=-1)
    o_q_norm = 1.0 + nrm((O, C_QL), 0.02)
    o_kv_norm = 1.0 + nrm((O, C_KVL), 0.02)
    o_w_qb = nrm((O, C_QL, C_HEADS * (C_DN + C_DR)), C_QL ** -0.5)
    o_w_uk = nrm((O, C_KVL, C_HEADS, C_DN), C_KVL ** -0.5)
    o_w_uv = nrm((O, C_KVL, C_HEADS, C_DV), C_KVL ** -0.5 * DN_BETA)
    o_w_iq = nrm((O, C_QL, C_IDX_HEADS * C_IDX_DH), C_QL ** -0.5)
    o_ik_g = 1.0 + nrm((O, C_IDX_DH), 0.02)
    o_ik_b = nrm((O, C_IDX_DH), 0.02)
    o_w_out = nrm((O, C_HEADS * C_DV, D), (C_HEADS * C_DV) ** -0.5 * DN_BETA)
    ln1_g = 1.0 + nrm((L, D), 0.02)
    ln1_b = nrm((L, D), 0.02)
    ln2_g = 1.0 + nrm((L, D), 0.02)
    ln2_b = nrm((L, D), 0.02)
    mlp_w1 = nrm((L, D, D_FF), sD * DN_BETA)
    mlp_w2 = nrm((L, D_FF, D), D_FF ** -0.5 * DN_BETA)
    ple_gate_w = nrm((L, D, D), sD)
    ple_w = nrm((L, D_PLE, D), D_PLE ** -0.5)
    return {'x': x, 'p': p, 'positions': positions,
            'e_w_in': e_w_in, 'e_a_conv': e_a_conv, 'e_a_i_b': e_a_i_b, 'e_a_f_b': e_a_f_b, 'e_a_norm': e_a_norm,
            'e_b_cmp_pos': e_b_cmp_pos, 'e_b_cmp_w1': e_b_cmp_w1, 'e_b_cmp_w2': e_b_cmp_w2, 'e_b_g_b': e_b_g_b,
            'e_w_out': e_w_out,
            'o_w_in': o_w_in, 'o_q_norm': o_q_norm, 'o_kv_norm': o_kv_norm, 'o_w_qb': o_w_qb, 'o_w_uk': o_w_uk,
            'o_w_uv': o_w_uv, 'o_w_iq': o_w_iq, 'o_ik_g': o_ik_g, 'o_ik_b': o_ik_b, 'o_w_out': o_w_out,
            'ln1_g': ln1_g, 'ln1_b': ln1_b, 'ln2_g': ln2_g, 'ln2_b': ln2_b, 'mlp_w1': mlp_w1, 'mlp_w2': mlp_w2,
            'ple_gate_w': ple_gate_w, 'ple_w': ple_w}


def reference(x, p, positions,
              e_w_in, e_a_conv, e_a_i_b, e_a_f_b, e_a_norm, e_b_cmp_pos, e_b_cmp_w1, e_b_cmp_w2, e_b_g_b, e_w_out,
              o_w_in, o_q_norm, o_kv_norm, o_w_qb, o_w_uk, o_w_uv, o_w_iq, o_ik_g, o_ik_b, o_w_out,
              ln1_g, ln1_b, ln2_g, ln2_b, mlp_w1, mlp_w2, ple_gate_w, ple_w):
    h = x
    for i in range(DEPTH):
        j = i // 2
        if i % 2 == 0:
            y = _even_mixer(h, e_w_in[j], e_a_conv[j], e_a_i_b[j], e_a_f_b[j], e_a_norm[j], e_b_cmp_pos[j],
                            e_b_cmp_w1[j], e_b_cmp_w2[j], e_b_g_b[j], e_w_out[j])
        else:
            y = _odd_mixer(h, positions, o_w_in[j], o_q_norm[j], o_kv_norm[j], o_w_qb[j], o_w_uk[j], o_w_uv[j],
                           o_w_iq[j], o_ik_g[j], o_ik_b[j], o_w_out[j])
        h = _layer_norm(DN_ALPHA * h + y, ln1_g[i], ln1_b[i])
        u = jnp.square(jax.nn.relu(h @ mlp_w1[i])) @ mlp_w2[i]
        h = _layer_norm(DN_ALPHA * h + u, ln2_g[i], ln2_b[i])
        h = h + jax.nn.sigmoid(h @ ple_gate_w[i]) * (p[i] @ ple_w[i])
    return h
```

```cpp
#include <hip/hip_runtime.h>
#include <hip/hip_cooperative_groups.h>
#include <cstdio>
#include <cstdint>
namespace cg = cooperative_groups;

#define LAS __attribute__((address_space(3)))
typedef unsigned char uchar;
typedef unsigned short bf16_t;
typedef short bf16x8 __attribute__((ext_vector_type(8)));
typedef short s16x4 __attribute__((ext_vector_type(4)));
typedef float f32x4 __attribute__((ext_vector_type(4)));
typedef unsigned u32x4 __attribute__((ext_vector_type(4)));
typedef unsigned u32x2 __attribute__((ext_vector_type(2)));

__device__ __forceinline__ int opaque_tid() { int t = threadIdx.x; asm volatile("" : "+v"(t)); return t; }

namespace pg8 {
#define PG8_LAS __attribute__((address_space(3)))
constexpr int BM = 256, BK = 64, HALF = 128, HTB = HALF * BK * 2, STAGE_BYTES = 8 * HTB, NXCD = 8, WGM = 8;
__host__ __device__ __forceinline__ int lds_byte(int r, int c) { const int st = (r >> 4) * 2 + (c >> 5), rr = r & 15, cc = c & 31, ob = rr * 64 + cc * 2; return st * 1024 + (ob ^ (((ob >> 9) & 1) << 5)); }
__host__ __device__ __forceinline__ void stage_rc(int b, int& R, int& C) { const int st = b / 1024, sb = b % 1024, swz = sb ^ (((sb >> 9) & 1) << 5); R = (st >> 1) * 16 + swz / 64; C = (st & 1) * 32 + (swz % 64) / 2; }
__host__ __device__ __forceinline__ int perm32(int rho) { const int n = rho >> 4, i = rho & 15; return 8 * (i >> 2) + 4 * n + (i & 3); }
struct Unit { int pm, pn; };
struct Gemm { const bf16_t* A; const bf16_t* Bt; int M, N, K, lda; };
struct StaticOrder {
    int nM, nN, nwg, G, c;
    __host__ __device__ void init(int M, int N, int G_, int c_) { nM = M / BM; nN = N / BM; nwg = nM * nN; G = G_; c = c_; }
    __host__ __device__ bool next(int i, Unit& u) const {
        const long L = (long)i * G + c; if (L >= nwg) return false;
        int wgid = (int)L; { const int q = nwg / NXCD, r = nwg % NXCD, xcd = wgid % NXCD, off = wgid / NXCD; wgid = (xcd < r ? xcd * (q + 1) : r * (q + 1) + (xcd - r) * q) + off; }
        const int nig = WGM * nN, gid = wgid / nig, fm = gid * WGM, gsz = (nM - fm) < WGM ? (nM - fm) : WGM;
        u.pm = fm + ((wgid % nig) % gsz); u.pn = (wgid % nig) / gsz; return true;
    }
    __device__ __forceinline__ void a_ready(const Unit&) const {}
    __device__ __forceinline__ void done(const Unit&) const {}
};
__device__ __forceinline__ unsigned cvt_pk_bf16(float lo, float hi) { unsigned r; asm volatile("v_cvt_pk_bf16_f32 %0, %1, %2" : "=v"(r) : "v"(lo), "v"(hi)); return r; }
template <class F> struct Epi8 {
    static constexpr bool PERM = true, AFTER_DRAIN = false; F f;
    __device__ __forceinline__ void operator()(const f32x4 (&acc)[2][2][4][2], const Unit& u, int wr, int wc, int fr, int fq) const {
#pragma unroll
        for (int ai = 0; ai < 2; ++ai)
#pragma unroll
            for (int m = 0; m < 4; ++m)
#pragma unroll
                for (int bj = 0; bj < 2; ++bj) {
                    const int row = u.pm * BM + ai * HALF + wr * 64 + m * 16 + fr, col = u.pn * BM + bj * HALF + wc * 32 + 8 * fq;
                    f(row, col, acc[ai][bj][m][0], acc[ai][bj][m][1]);
                }
    }
};
template <class Epi, class Sched, bool ALIGN_EPI = false, bool SP2 = false>
__device__ __forceinline__ void gemm_phase(PG8_LAS unsigned char* lds, const Gemm g, const Sched& S, const Epi& E) {
    const int tid = opaque_tid(), wid = __builtin_amdgcn_readfirstlane(tid >> 6), lane = tid & 63, wr = wid >> 2, wc = wid & 3, fr = lane & 15, fq = lane >> 4;
    const int K = g.K, nt = K / BK;
    unsigned voffA[2], voffB[2];
#pragma unroll
    for (int i = 0; i < 2; ++i) { int R, C; stage_rc(tid * 16 + i * 8192, R, C); const int Rb = Epi::PERM ? ((R & ~31) + perm32(R & 31)) : R;
        voffA[i] = (unsigned)(R * g.lda + C) * 2u; voffB[i] = (unsigned)(Rb * K + C) * 2u; }
    const size_t kstep = (size_t)(BK * 2);
    const size_t hstepA = (size_t)HALF * g.lda * 2, hstepB = (size_t)HALF * K * 2;
    const size_t tstepA = 2 * hstepA, tstepB = 2 * hstepB;
    const unsigned ldsw = (unsigned)wid * 1024u;
    const int aoff = lds_byte(wr * 64 + fr, fq * 8), boff = lds_byte(wc * 32 + fr, fq * 8);
#define PG8_SA(b, h) (((b) * 2 + (h)) * HTB)
#define PG8_SB(b, h) ((4 + (b) * 2 + (h)) * HTB)
#define PG8_STAGE(bufoff, gbase, voff) do { _Pragma("unroll") for (int _i = 0; _i < 2; ++_i) \
        __builtin_amdgcn_global_load_lds((const unsigned*)((const char*)(gbase) + (voff)[_i]), (PG8_LAS unsigned*)(lds + (bufoff) + ldsw + _i * 8192), 16, 0, 0); } while (0)
#define PG8_LDA(dst, b, h) do { _Pragma("unroll") for (int m = 0; m < 4; ++m) _Pragma("unroll") for (int k = 0; k < 2; ++k) dst[m][k] = *(const PG8_LAS bf16x8*)(lds + PG8_SA(b, h) + aoff + m * 2048 + k * 1024); } while (0)
#define PG8_LDB(dst, b, h) do { _Pragma("unroll") for (int n = 0; n < 2; ++n) _Pragma("unroll") for (int k = 0; k < 2; ++k) dst[n][k] = *(const PG8_LAS bf16x8*)(lds + PG8_SB(b, h) + boff + n * 2048 + k * 1024); } while (0)
#define PG8_MMA(ai, bj, At, Bt) do { __builtin_amdgcn_s_setprio(1); _Pragma("unroll") for (int m = 0; m < 4; ++m) _Pragma("unroll") for (int n = 0; n < 2; ++n) _Pragma("unroll") for (int k = 0; k < 2; ++k) \
        acc[ai][bj][m][n] = __builtin_amdgcn_mfma_f32_16x16x32_bf16(Bt[n][k], At[m][k], acc[ai][bj][m][n], 0, 0, 0); __builtin_amdgcn_s_setprio(0); } while (0)
#define PG8_WAIT_V(n) asm volatile("s_waitcnt vmcnt(" #n ")" ::: "memory")
#define PG8_WAIT_L(n) asm volatile("s_waitcnt lgkmcnt(" #n ")" ::: "memory")
#define PG8_BAR __builtin_amdgcn_s_barrier()
#define PG8_SCHED __builtin_amdgcn_sched_barrier(0)
    Unit cur, nxt; int ui = 0;
    if (!S.next(0, cur)) return;
    f32x4 acc[2][2][4][2];
#pragma unroll
    for (int a = 0; a < 2; ++a)
#pragma unroll
        for (int b = 0; b < 2; ++b)
#pragma unroll
            for (int m = 0; m < 4; ++m)
#pragma unroll
                for (int n = 0; n < 2; ++n) acc[a][b][m][n] = (f32x4){0.f, 0.f, 0.f, 0.f};
    bf16x8 At[4][2], B0[2][2], B1[2][2];
    const char* cA = (const char*)g.A + (size_t)cur.pm * tstepA; const char* cB = (const char*)g.Bt + (size_t)cur.pn * tstepB;
    S.a_ready(cur);
    if constexpr (SP2) {
        PG8_STAGE(PG8_SB(0, 0), cB, voffB); PG8_STAGE(PG8_SB(0, 1), cB + hstepB, voffB); PG8_STAGE(PG8_SA(0, 0), cA, voffA); PG8_STAGE(PG8_SA(0, 1), cA + hstepA, voffA);
        if (wr == 1) PG8_BAR;
        PG8_WAIT_V(2); PG8_BAR;
        PG8_STAGE(PG8_SB(1, 0), cB + kstep, voffB); PG8_STAGE(PG8_SA(1, 0), cA + kstep, voffA); PG8_STAGE(PG8_SB(1, 1), cB + hstepB + kstep, voffB);
        PG8_WAIT_V(6); PG8_BAR;
    } else {
        PG8_STAGE(PG8_SB(0, 0), cB, voffB); PG8_STAGE(PG8_SA(0, 0), cA, voffA); PG8_STAGE(PG8_SB(0, 1), cB + hstepB, voffB); PG8_STAGE(PG8_SA(0, 1), cA + hstepA, voffA);
        if (wr == 1) PG8_BAR;
        PG8_WAIT_V(4); PG8_BAR;
        PG8_STAGE(PG8_SB(1, 0), cB + kstep, voffB); PG8_STAGE(PG8_SA(1, 0), cA + kstep, voffA); PG8_STAGE(PG8_SB(1, 1), cB + hstepB + kstep, voffB);
        PG8_WAIT_V(6); PG8_BAR;
    }
    for (;;) {
        const bool has_next = S.next(ui + 1, nxt);
        const char* nA = has_next ? (const char*)g.A + (size_t)nxt.pm * tstepA : cA; const char* nB = has_next ? (const char*)g.Bt + (size_t)nxt.pn * tstepB : cB;
        for (int t = 0; t < nt; t += 2) {
            const bool last = (t == nt - 2);
            const char* a1 = cA + (size_t)(t + 1) * kstep;
            const char* a2 = last ? nA : cA + (size_t)(t + 2) * kstep; const char* b2 = last ? nB : cB + (size_t)(t + 2) * kstep;
            const char* a3 = a2 + kstep; const char* b3 = b2 + kstep;
            if (last && has_next) S.a_ready(nxt);
            if constexpr (SP2) {
            PG8_LDB(B0, 0, 0); PG8_LDB(B1, 0, 1); PG8_SCHED; PG8_LDA(At, 0, 0); PG8_STAGE(PG8_SA(1, 1), a1 + hstepA, voffA);
            PG8_WAIT_V(8); PG8_WAIT_L(0); PG8_BAR; PG8_MMA(0, 0, At, B0); PG8_MMA(0, 1, At, B1); PG8_BAR; PG8_SCHED;
            PG8_LDA(At, 0, 1); PG8_STAGE(PG8_SB(0, 0), b2, voffB); PG8_STAGE(PG8_SB(0, 1), b2 + hstepB, voffB); PG8_STAGE(PG8_SA(0, 0), a2, voffA);
            PG8_WAIT_V(8); PG8_WAIT_L(0); PG8_BAR; PG8_MMA(1, 0, At, B0); PG8_MMA(1, 1, At, B1); PG8_BAR; PG8_SCHED;
            PG8_LDB(B0, 1, 0); PG8_LDB(B1, 1, 1); PG8_SCHED; PG8_LDA(At, 1, 0); PG8_STAGE(PG8_SA(0, 1), a2 + hstepA, voffA);
            PG8_WAIT_V(8); PG8_WAIT_L(0); PG8_BAR; PG8_MMA(0, 0, At, B0); PG8_MMA(0, 1, At, B1); PG8_BAR; PG8_SCHED;
            PG8_LDA(At, 1, 1); PG8_STAGE(PG8_SB(1, 0), b3, voffB); PG8_STAGE(PG8_SB(1, 1), b3 + hstepB, voffB); PG8_STAGE(PG8_SA(1, 0), a3, voffA);
            PG8_WAIT_V(8); PG8_WAIT_L(0); PG8_BAR; PG8_MMA(1, 0, At, B0); PG8_MMA(1, 1, At, B1); PG8_BAR; PG8_SCHED;
            } else {
            PG8_LDB(B0, 0, 0); PG8_SCHED; PG8_LDA(At, 0, 0); PG8_STAGE(PG8_SA(1, 1), a1 + hstepA, voffA);
            PG8_WAIT_L(8); PG8_BAR; PG8_WAIT_L(0); PG8_MMA(0, 0, At, B0); PG8_BAR; PG8_SCHED;
            PG8_LDB(B1, 0, 1); PG8_STAGE(PG8_SB(0, 0), b2, voffB);
            PG8_BAR; PG8_WAIT_L(0); PG8_MMA(0, 1, At, B1); PG8_BAR;
            PG8_LDA(At, 0, 1); PG8_STAGE(PG8_SA(0, 0), a2, voffA);
            PG8_BAR; PG8_WAIT_L(0); PG8_MMA(1, 0, At, B0); PG8_BAR; PG8_SCHED;
            PG8_STAGE(PG8_SB(0, 1), b2 + hstepB, voffB);
            PG8_WAIT_V(6); PG8_BAR; PG8_MMA(1, 1, At, B1); PG8_BAR;
            PG8_LDB(B0, 1, 0); PG8_SCHED; PG8_LDA(At, 1, 0); PG8_STAGE(PG8_SA(0, 1), a2 + hstepA, voffA);
            PG8_WAIT_L(8); PG8_BAR; PG8_WAIT_L(0); PG8_MMA(0, 0, At, B0); PG8_BAR; PG8_SCHED;
            PG8_LDB(B1, 1, 1); PG8_STAGE(PG8_SB(1, 0), b3, voffB);
            PG8_BAR; PG8_WAIT_L(0); PG8_MMA(0, 1, At, B1); PG8_BAR;
            PG8_LDA(At, 1, 1); PG8_STAGE(PG8_SA(1, 0), a3, voffA);
            PG8_BAR; PG8_WAIT_L(0); PG8_MMA(1, 0, At, B0); PG8_BAR; PG8_SCHED;
            PG8_STAGE(PG8_SB(1, 1), b3 + hstepB, voffB);
            PG8_WAIT_V(6); PG8_BAR; PG8_MMA(1, 1, At, B1); PG8_BAR;
            }
        }
        if constexpr (ALIGN_EPI) { if (wr == 0) PG8_BAR; }
        if constexpr (!Epi::AFTER_DRAIN) { E(acc, cur, wr, wc, fr, fq); S.done(cur); }
        if (!has_next) break;
#pragma unroll
        for (int a = 0; a < 2; ++a)
#pragma unroll
            for (int b = 0; b < 2; ++b)
#pragma unroll
                for (int m = 0; m < 4; ++m)
#pragma unroll
                    for (int n = 0; n < 2; ++n) acc[a][b][m][n] = (f32x4){0.f, 0.f, 0.f, 0.f};
        cur = nxt; cA = nA; cB = nB; ++ui;
        if constexpr (ALIGN_EPI) { if (wr == 1) PG8_BAR; }
    }
    PG8_WAIT_V(0);
    if constexpr (!ALIGN_EPI) { if (wr == 0) PG8_BAR; }
    PG8_BAR;
    if constexpr (Epi::AFTER_DRAIN) { E.fused(acc, cur, wr, wc, fr, fq, lds, wid, lane); S.done(cur); }
#undef PG8_SA
#undef PG8_SB
#undef PG8_STAGE
#undef PG8_LDA
#undef PG8_LDB
#undef PG8_MMA
#undef PG8_WAIT_V
#undef PG8_WAIT_L
#undef PG8_BAR
#undef PG8_SCHED
}}
using pg8::Gemm; using pg8::StaticOrder; using pg8::Epi8;

constexpr int NB = 8, T = 4096, M = NB * T, D = 1024;
constexpr float DN_ALPHA = 1.6817928305074292f;
constexpr float LN_EPS = 1e-5f, NEGF = -1e30f;
constexpr int ZE = 3584;
constexpr int C_AQ = 0, C_AK = 512, C_AV = 1024, C_AO = 1536, C_AI = 2048, C_AF = 2052, C_BQ = 2056, C_BKC = 2568, C_BVC = 2696, C_BKS = 2824, C_BVS = 2952, C_BKW = 3080, C_BVW = 3208, C_BG = 3336;
constexpr size_t MiB = 1u << 20;
constexpr size_t WS_WB = 0, WSLOT = 29 * MiB, WS_HB = 116 * MiB, WS_R1 = 180 * MiB, WS_R2 = 436 * MiB, WS_MISC = 500 * MiB, WS_NEED = 512 * MiB;
constexpr size_t OW1 = 0, OW2 = 4194304, OWG = 8388608, OWP = 9437184, OA = 9699328, OWOUT = OA + 3670016, OCW1 = OWOUT + 1048576, OCW2 = OCW1 + 524288, OWQ = OA + 1048576, OWF = OWQ + 1572864;
static_assert((OCW2 + 16384) * 2 <= WSLOT && (OWF + 2097152) * 2 <= WSLOT, "weight slot");
constexpr int LDS_BYTES = 147456;
constexpr int NTHR = 512;

struct KArgs { const void* in[31]; float* out; uchar* ws; int ph_lo, ph_hi; };
#define GAS __attribute__((address_space(1)))

__device__ __forceinline__ unsigned f2bf(float f) { unsigned u = __float_as_uint(f); return (u + 0x7fffu + ((u >> 16) & 1u)) >> 16; }
__device__ __forceinline__ float bflo(unsigned w) { return __uint_as_float(w << 16); }
__device__ __forceinline__ float bfhi(unsigned w) { return __uint_as_float(w & 0xffff0000u); }
__device__ __forceinline__ float bf2f(bf16_t b) { return __uint_as_float(((unsigned)b) << 16); }
typedef float f32x2_t __attribute__((ext_vector_type(2)));
typedef __bf16 bf16x2_t __attribute__((ext_vector_type(2)));
__device__ __forceinline__ unsigned pk2(float lo, float hi) { f32x2_t v = {lo, hi}; bf16x2_t b = __builtin_convertvector(v, bf16x2_t); return __builtin_bit_cast(unsigned, b); }
__device__ __forceinline__ float wave_sum(float v) {
#pragma unroll
    for (int o = 32; o; o >>= 1) v += __shfl_xor(v, o);
    return v; }
__device__ __forceinline__ f32x4 mfma16(bf16x8 a, bf16x8 b, f32x4 c) { return __builtin_amdgcn_mfma_f32_16x16x32_bf16(a, b, c, 0, 0, 0); }
__device__ __forceinline__ bf16x8 ldsv(LAS const uchar* p) { return *(const LAS bf16x8*)p; }
__device__ __forceinline__ s16x4 tr16(LAS const uchar* p) { return __builtin_bit_cast(s16x4, __builtin_amdgcn_ds_read_tr16_b64_v4i16((LAS s16x4*)p)); }
__device__ __forceinline__ bf16x8 cat4(s16x4 a, s16x4 b) { bf16x8 r; r[0] = a[0]; r[1] = a[1]; r[2] = a[2]; r[3] = a[3]; r[4] = b[0]; r[5] = b[1]; r[6] = b[2]; r[7] = b[3]; return r; }
__device__ __forceinline__ bf16x8 gldv(const bf16_t* p) { return __builtin_bit_cast(bf16x8, *(const u32x4*)p); }
__device__ __forceinline__ bf16x8 gldvg(GAS const bf16_t* p) { return __builtin_bit_cast(bf16x8, *(GAS const u32x4*)p); }
__device__ __forceinline__ bf16x8 pack8(f32x4 a, f32x4 b) { u32x4 w; w.x = pk2(a[0], a[1]); w.y = pk2(a[2], a[3]); w.z = pk2(b[0], b[1]); w.w = pk2(b[2], b[3]); return __builtin_bit_cast(bf16x8, w); }
__device__ __forceinline__ float sigmoidf_(float x) { return 1.0f / (1.0f + __expf(-x)); }
__device__ __forceinline__ void sincos_rev(float ang, float& s, float& c) { float r = ang * 0.15915494309189535f; r -= floorf(r); s = __builtin_amdgcn_sinf(r); c = __builtin_amdgcn_cosf(r); }
#define WG_SYNC() __syncthreads()

struct FStoreBf16 { bf16_t* O; int ldc; int relu2;
    __device__ __forceinline__ void operator()(int row, int col, f32x4 a, f32x4 b) const {
        if (relu2) {
#pragma unroll
            for (int i = 0; i < 4; ++i) { float x = fmaxf(a[i], 0.f); a[i] = x * x; float y = fmaxf(b[i], 0.f); b[i] = y * y; } }
        u32x4 w; w.x = pk2(a[0], a[1]); w.y = pk2(a[2], a[3]); w.z = pk2(b[0], b[1]); w.w = pk2(b[2], b[3]);
        *(GAS u32x4*)((GAS bf16_t*)O + (size_t)row * ldc + col) = w; } };
struct FResid { const float* Hs; float* H; float alpha;
    __device__ __forceinline__ void operator()(int row, int col, f32x4 a, f32x4 b) const {
        const size_t o = (size_t)row * D + col; const f32x4 h0 = *(GAS const f32x4*)((GAS const float*)Hs + o), h1 = *(GAS const f32x4*)((GAS const float*)Hs + o + 4);
        *(GAS f32x4*)((GAS float*)H + o) = h0 * alpha + a; *(GAS f32x4*)((GAS float*)H + o + 4) = h1 * alpha + b; } };
struct FResidLn { float* H; const float* ST; const float* g; const float* b;
    __device__ __forceinline__ void operator()(int row, int col, f32x4 a, f32x4 c) const {
        GAS float* p = (GAS float*)H + (size_t)row * D + col; const f32x4 x0 = *(GAS f32x4*)p, x1 = *(GAS f32x4*)(p + 4);
        const float mu = ((GAS const float*)ST)[2 * row], rs = ((GAS const float*)ST)[2 * row + 1];
        GAS const float* gg = (GAS const float*)g + col; GAS const float* bb = (GAS const float*)b + col;
        const f32x4 g0 = *(GAS const f32x4*)gg, g1 = *(GAS const f32x4*)(gg + 4), b0 = *(GAS const f32x4*)bb, b1 = *(GAS const f32x4*)(bb + 4);
        *(GAS f32x4*)p = ((x0 - mu) * rs * g0 + b0) * DN_ALPHA + a; *(GAS f32x4*)(p + 4) = ((x1 - mu) * rs * g1 + b1) * DN_ALPHA + c; } };
struct FGateLn { float* H; bf16_t* HB; const bf16_t* PE; const float* ST; const float* g; const float* b;
    __device__ __forceinline__ void operator()(int row, int col, f32x4 a, f32x4 c) const {
        const size_t o = (size_t)row * D + col; GAS float* p = (GAS float*)H + o; const f32x4 x0 = *(GAS f32x4*)p, x1 = *(GAS f32x4*)(p + 4); const u32x4 pe = *(GAS const u32x4*)((GAS const bf16_t*)PE + o);
        const float mu = ((GAS const float*)ST)[2 * row], rs = ((GAS const float*)ST)[2 * row + 1];
        GAS const float* gg = (GAS const float*)g + col; GAS const float* bb = (GAS const float*)b + col;
        const f32x4 g0 = *(GAS const f32x4*)gg, g1 = *(GAS const f32x4*)(gg + 4), b0 = *(GAS const f32x4*)bb, b1 = *(GAS const f32x4*)(bb + 4);
        f32x4 h0 = (x0 - mu) * rs * g0 + b0, h1 = (x1 - mu) * rs * g1 + b1;
        h0[0] += sigmoidf_(a[0]) * bflo(pe.x); h0[1] += sigmoidf_(a[1]) * bfhi(pe.x); h0[2] += sigmoidf_(a[2]) * bflo(pe.y); h0[3] += sigmoidf_(a[3]) * bfhi(pe.y);
        h1[0] += sigmoidf_(c[0]) * bflo(pe.z); h1[1] += sigmoidf_(c[1]) * bfhi(pe.z); h1[2] += sigmoidf_(c[2]) * bflo(pe.w); h1[3] += sigmoidf_(c[3]) * bfhi(pe.w);
        *(GAS f32x4*)p = h0; *(GAS f32x4*)(p + 4) = h1;
        u32x4 w; w.x = pk2(h0[0], h0[1]); w.y = pk2(h0[2], h0[3]); w.z = pk2(h1[0], h1[1]); w.w = pk2(h1[2], h1[3]); *(GAS u32x4*)((GAS bf16_t*)HB + o) = w; } };
struct FGate { float* H; bf16_t* HB; const bf16_t* PE;
    __device__ __forceinline__ void operator()(int row, int col, f32x4 a, f32x4 b) const {
        const size_t o = (size_t)row * D + col; float* p = H + o; f32x4 h0 = *(f32x4*)p, h1 = *(f32x4*)(p + 4); const u32x4 pe = *(const u32x4*)(PE + o);
        h0[0] += sigmoidf_(a[0]) * bflo(pe.x); h0[1] += sigmoidf_(a[1]) * bfhi(pe.x); h0[2] += sigmoidf_(a[2]) * bflo(pe.y); h0[3] += sigmoidf_(a[3]) * bfhi(pe.y);
        h1[0] += sigmoidf_(b[0]) * bflo(pe.z); h1[1] += sigmoidf_(b[1]) * bfhi(pe.z); h1[2] += sigmoidf_(b[2]) * bflo(pe.w); h1[3] += sigmoidf_(b[3]) * bfhi(pe.w);
        *(f32x4*)p = h0; *(f32x4*)(p + 4) = h1;
        u32x4 w; w.x = pk2(h0[0], h0[1]); w.y = pk2(h0[2], h0[3]); w.z = pk2(h1[0], h1[1]); w.w = pk2(h1[2], h1[3]); *(u32x4*)(HB + o) = w; } };
struct FQ2 { bf16_t* Q2; const int* pos;
    __device__ __forceinline__ void operator()(int row, int col, f32x4 a, f32x4 b) const {
        GAS bf16_t* rp = (GAS bf16_t*)Q2 + (size_t)row * 3072;
        if (col < 2048) { u32x4 w; w.x = pk2(a[0], a[1]); w.y = pk2(a[2], a[3]); w.z = pk2(b[0], b[1]); w.w = pk2(b[2], b[3]); *(GAS u32x4*)(rp + col) = w; return; }
        const float ps = (float)((GAS const int*)pos)[row];
        int e, half, i0; float lg;
        if (col < 2560) { e = col - 2048; half = 32; lg = 13.287712379549449f * (2.0f / 64.0f); }
        else { e = col - 2560; half = 16; lg = 13.287712379549449f * (2.0f / 32.0f);
            if ((e & 63) >= 32) { u32x4 w; w.x = pk2(a[0], a[1]); w.y = pk2(a[2], a[3]); w.z = pk2(b[0], b[1]); w.w = pk2(b[2], b[3]); *(GAS u32x4*)(rp + col) = w; return; } }
        const int hb = (col - (e & 63)); i0 = (e & 63) >> 1;
        float x1[4] = {a[0], a[2], b[0], b[2]}, x2[4] = {a[1], a[3], b[1], b[3]}, o1[4], o2[4];
#pragma unroll
        for (int i = 0; i < 4; ++i) { const float inv = exp2f(-(float)(i0 + i) * lg); float s, c; sincos_rev(ps * inv, s, c); o1[i] = x1[i] * c - x2[i] * s; o2[i] = x1[i] * s + x2[i] * c; }
        u32x2 w1, w2; w1.x = pk2(o1[0], o1[1]); w1.y = pk2(o1[2], o1[3]); w2.x = pk2(o2[0], o2[1]); w2.y = pk2(o2[2], o2[3]);
        *(GAS u32x2*)(rp + hb + i0) = w1; *(GAS u32x2*)(rp + hb + half + i0) = w2; } };

template <class F> __device__ __forceinline__ void run_gemm(LAS uchar* lds, const bf16_t* A, int lda, const bf16_t* Bt, int Mr, int N, int K, const F& f) {
    Gemm g{A, Bt, Mr, N, K, lda}; StaticOrder S; S.init(Mr, N, (int)gridDim.x, (int)blockIdx.x); Epi8<F> E{f};
    pg8::gemm_phase<Epi8<F>, StaticOrder, true, true>(lds, g, S, E);
    WG_SYNC();
}

__device__ __forceinline__ void conv_T(const float* W, int K, int N, int Npad, bf16_t* WT, LAS float* tile0) {
    const int tid = opaque_tid(), lane = tid & 63, w = tid >> 6, nk = K / 64, nn = Npad / 64;
    LAS float* tile = tile0 + w * (64 * 65 + 16);
    int gw = blockIdx.x * 8 + w; asm volatile("" : "+v"(gw));
    const int nw = gridDim.x * 8;
    for (int item = gw; item < nk * nn; item += nw) {
        const int kt = item / nn, nt = item % nn;
        if ((N & 3) == 0) {
            f32x4 v[16];
#pragma unroll
            for (int i = 0; i < 16; ++i) { const int r = (lane >> 4) + 4 * i, c = (lane & 15) * 4, n = nt * 64 + c; v[i] = (f32x4){0.f, 0.f, 0.f, 0.f}; if (n < N) v[i] = *(const f32x4*)(W + (size_t)(kt * 64 + r) * N + n); }
#pragma unroll
            for (int i = 0; i < 16; ++i) { const int r = (lane >> 4) + 4 * i, c = (lane & 15) * 4; tile[r * 65 + c] = v[i][0]; tile[r * 65 + c + 1] = v[i][1]; tile[r * 65 + c + 2] = v[i][2]; tile[r * 65 + c + 3] = v[i][3]; }
        } else {
#pragma unroll 8
            for (int r = 0; r < 64; ++r) { const int n = nt * 64 + lane; tile[r * 65 + lane] = n < N ? W[(size_t)(kt * 64 + r) * N + n] : 0.f; }
        }
        asm volatile("s_waitcnt lgkmcnt(0)" ::: "memory");
#pragma unroll
        for (int i = 0; i < 8; ++i) { const int n = (lane >> 3) + 8 * i, kg = (lane & 7) * 8; u32x4 o;
            o.x = pk2(tile[(kg + 0) * 65 + n], tile[(kg + 1) * 65 + n]); o.y = pk2(tile[(kg + 2) * 65 + n], tile[(kg + 3) * 65 + n]);
            o.z = pk2(tile[(kg + 4) * 65 + n], tile[(kg + 5) * 65 + n]); o.w = pk2(tile[(kg + 6) * 65 + n], tile[(kg + 7) * 65 + n]);
            *(u32x4*)(WT + (size_t)(nt * 64 + n) * K + kt * 64 + kg) = o; }
        asm volatile("s_waitcnt lgkmcnt(0)" ::: "memory");
    }
}

__device__ __forceinline__ void prologue(const KArgs& a, LAS uchar* lds) {
    LAS float* tile = (LAS float*)lds;
    bf16_t* WB = (bf16_t*)(a.ws + WS_WB);
    const int tid = opaque_tid(), lane = tid & 63, gw = blockIdx.x * 8 + (tid >> 6), nw = gridDim.x * 8;
    for (int L = 0; L < 4; ++L) {
        const int j = L >> 1; bf16_t* sl = WB + (size_t)L * (WSLOT / 2);
        conv_T((const float*)a.in[27] + (size_t)L * 1024 * 4096, 1024, 4096, 4096, sl + OW1, tile);
        conv_T((const float*)a.in[28] + (size_t)L * 4096 * 1024, 4096, 1024, 1024, sl + OW2, tile);
        conv_T((const float*)a.in[29] + (size_t)L * 1024 * 1024, 1024, 1024, 1024, sl + OWG, tile);
        conv_T((const float*)a.in[30] + (size_t)L * 256 * 1024, 256, 1024, 1024, sl + OWP, tile);
        if ((L & 1) == 0) {
            conv_T((const float*)a.in[3] + (size_t)j * 1024 * 3360, 1024, 3360, 3584, sl + OA, tile);
            conv_T((const float*)a.in[12] + (size_t)j * 1024 * 1024, 1024, 1024, 1024, sl + OWOUT, tile);
            for (int jk = 0; jk < 2; ++jk) {
                conv_T((const float*)a.in[9] + (size_t)(j * 2 + jk) * 2048 * 128, 2048, 128, 128, sl + OCW1 + (size_t)jk * 128 * 2048, tile);
                conv_T((const float*)a.in[10] + (size_t)(j * 2 + jk) * 128 * 64, 128, 64, 64, sl + OCW2 + (size_t)jk * 64 * 128, tile);
            }
        } else {
            conv_T((const float*)a.in[13] + (size_t)j * 1024 * 904, 1024, 904, 1024, sl + OA, tile);
            const float* wqb = (const float*)a.in[16] + (size_t)j * 512 * 1536;
            const float* wuk = (const float*)a.in[17] + (size_t)j * 256 * 1024;
            const float* wuv = (const float*)a.in[18] + (size_t)j * 256 * 1024;
            const float* wiq = (const float*)a.in[19] + (size_t)j * 512 * 512;
            const float* wout = (const float*)a.in[22] + (size_t)j * 1024 * 1024;
            bf16_t* WQ = sl + OWQ; bf16_t* WF = sl + OWF;
            const float qs = 0.07216878364870322f;
            for (int tl = gw; tl < 8 * 16 * 32; tl += nw) {
                const int h = tl >> 9, ct = (tl >> 5) & 15, kt = tl & 31, c16 = lane & 15, hq = lane >> 4;
                f32x4 acc = {0.f, 0.f, 0.f, 0.f};
#pragma unroll
                for (int ks = 0; ks < 4; ++ks) {
                    const float* ap = wqb + (size_t)(kt * 16 + c16) * 1536 + h * 192 + 32 * ks + 8 * hq; const float* bp = wuk + (size_t)(ct * 16 + c16) * 1024 + h * 128 + 32 * ks + 8 * hq;
                    acc = mfma16(pack8(*(const f32x4*)ap, *(const f32x4*)(ap + 4)), pack8(*(const f32x4*)bp, *(const f32x4*)(bp + 4)), acc); }
                u32x2 o; o.x = pk2(acc[0] * qs, acc[1] * qs); o.y = pk2(acc[2] * qs, acc[3] * qs);
                *(u32x2*)(WQ + (size_t)(h * 256 + ct * 16 + c16) * 512 + kt * 16 + 4 * hq) = o;
            }
            for (int n = 2048 + gw; n < 3072; n += nw) {
                int col; float sc; const float* src; int ld;
                if (n < 2560) { const int e = n - 2048, h = e >> 6, ee = e & 63; col = h * 192 + 128 + (ee >> 1) + 32 * (ee & 1); sc = qs; src = wqb; ld = 1536; }
                else { const int e = n - 2560, h = e >> 6, ee = e & 63; const int dc = ee < 32 ? ((ee >> 1) + 16 * (ee & 1)) : ee; col = h * 64 + dc; sc = 1.f; src = wiq; ld = 512; }
#pragma unroll
                for (int i2 = 0; i2 < 8; ++i2) { const int k = lane + 64 * i2; WQ[(size_t)n * 512 + k] = (bf16_t)f2bf(src[(size_t)k * ld + col] * sc); }
            }
            for (int tl = gw; tl < 8 * 16 * 64; tl += nw) {
                const int h = tl >> 10, ct = (tl >> 6) & 15, nt = tl & 63, c16 = lane & 15, hq = lane >> 4;
                f32x4 acc = {0.f, 0.f, 0.f, 0.f};
#pragma unroll
                for (int ks = 0; ks < 4; ++ks) {
                    const float* ap = wuv + (size_t)(ct * 16 + c16) * 1024 + h * 128 + 32 * ks + 8 * hq; const float* bp = wout + (size_t)(h * 128 + 32 * ks + 8 * hq) * 1024 + nt * 16 + c16;
                    f32x4 b0, b1; b0[0] = bp[0]; b0[1] = bp[1024]; b0[2] = bp[2048]; b0[3] = bp[3072]; b1[0] = bp[4096]; b1[1] = bp[5120]; b1[2] = bp[6144]; b1[3] = bp[7168];
                    acc = mfma16(pack8(*(const f32x4*)ap, *(const f32x4*)(ap + 4)), pack8(b0, b1), acc); }
                u32x2 o; o.x = pk2(acc[0], acc[1]); o.y = pk2(acc[2], acc[3]);
                *(u32x2*)(WF + (size_t)(nt * 16 + c16) * 2048 + h * 256 + ct * 16 + 4 * hq) = o;
            }
        }
    }
    const float* x = (const float*)a.in[0]; bf16_t* HB = (bf16_t*)(a.ws + WS_HB);
    for (int row = gw; row < M; row += nw) {
#pragma unroll
        for (int i = 0; i < 4; ++i) { const size_t o = (size_t)row * D + i * 256 + lane * 4; const f32x4 v = *(const f32x4*)(x + o); u32x2 w; w.x = pk2(v[0], v[1]); w.y = pk2(v[2], v[3]); *(u32x2*)(HB + o) = w; }
    }
}

__device__ __forceinline__ void ln_pass(const float* H, const float* g, const float* bta, bf16_t* HB, const float* p, bf16_t* Pb, float* ST) {
    const int tid = opaque_tid(), lane = tid & 63, gw = blockIdx.x * 8 + (tid >> 6), nw = gridDim.x * 8;
    f32x4 gv[4], bv[4];
#pragma unroll
    for (int i = 0; i < 4; ++i) { gv[i] = *(const f32x4*)(g + i * 256 + lane * 4); bv[i] = *(const f32x4*)(bta + i * 256 + lane * 4); }
    for (int row = gw; row < M; row += nw) {
        f32x4 v[4]; float s = 0.f;
#pragma unroll
        for (int i = 0; i < 4; ++i) { v[i] = *(const f32x4*)(H + (size_t)row * D + i * 256 + lane * 4); s += (v[i][0] + v[i][1]) + (v[i][2] + v[i][3]); }
        const float mu = wave_sum(s) * (1.0f / 1024.0f); float q = 0.f;
#pragma unroll
        for (int i = 0; i < 4; ++i) { v[i] = v[i] - mu; q += (v[i][0] * v[i][0] + v[i][1] * v[i][1]) + (v[i][2] * v[i][2] + v[i][3] * v[i][3]); }
        const float rs = rsqrtf(wave_sum(q) * (1.0f / 1024.0f) + LN_EPS);
#pragma unroll
        for (int i = 0; i < 4; ++i) { const f32x4 y = v[i] * rs * gv[i] + bv[i]; const size_t o = (size_t)row * D + i * 256 + lane * 4; u32x2 w; w.x = pk2(y[0], y[1]); w.y = pk2(y[2], y[3]); *(u32x2*)(HB + o) = w; }
        if (lane == 0) { ST[2 * row] = mu; ST[2 * row + 1] = rs; }
        if (p) { const f32x4 pv = *(const f32x4*)(p + (size_t)row * 256 + lane * 4); u32x2 w; w.x = pk2(pv[0], pv[1]); w.y = pk2(pv[2], pv[3]); *(u32x2*)(Pb + (size_t)row * 256 + lane * 4) = w; }
    }
}
__device__ __forceinline__ void compress_unit(const KArgs& a, int j, LAS uchar* lds, int unit, const bf16_t* Z, const bf16_t* sl, bf16_t* KC, bf16_t* VC) {
    const int tid = opaque_tid(), lane = tid & 63, w = __builtin_amdgcn_readfirstlane(tid >> 6), c16 = lane & 15, hq = lane >> 4;
    const int jk = unit >> 8, b = (unit >> 5) & 7, g = (unit >> 4) & 1, mt = unit & 15;
    const int zc = (jk ? C_BVC : C_BKC) + g * 64;
    const float* pos = (const float*)a.in[8] + (size_t)(j * 2 + jk) * 32 * 64;
    const bf16_t* W1 = sl + OCW1 + (size_t)jk * 128 * 2048; const bf16_t* W2 = sl + OCW2 + (size_t)jk * 64 * 128;
    int m = mt * 16 + c16; if (m > 254) m = 254;
    f32x4 acc = {0.f, 0.f, 0.f, 0.f};
    for (int k0 = 0; k0 < 64; k0 += 8) {
        u32x4 zz[8]; f32x4 pp0[8], pp1[8]; bf16x8 bb[8];
#pragma unroll
        for (int u = 0; u < 8; ++u) { const int ks = k0 + u, l = ks >> 1, d0 = (ks & 1) * 32 + 8 * hq;
            zz[u] = *(const u32x4*)(Z + (size_t)(b * T + m * 16 + l) * ZE + zc + d0);
            pp0[u] = *(const f32x4*)(pos + l * 64 + d0); pp1[u] = *(const f32x4*)(pos + l * 64 + d0 + 4);
            bb[u] = gldv(W1 + (size_t)(16 * w + c16) * 2048 + 32 * ks + 8 * hq); }
#pragma unroll
        for (int u = 0; u < 8; ++u) { const u32x4 z = zz[u]; const f32x4 p0 = pp0[u], p1 = pp1[u];
            u32x4 aw; aw.x = pk2(bflo(z.x) + p0[0], bfhi(z.x) + p0[1]); aw.y = pk2(bflo(z.y) + p0[2], bfhi(z.y) + p0[3]); aw.z = pk2(bflo(z.z) + p1[0], bfhi(z.z) + p1[1]); aw.w = pk2(bflo(z.w) + p1[2], bfhi(z.w) + p1[3]);
            acc = mfma16(__builtin_bit_cast(bf16x8, aw), bb[u], acc); }
    }
    LAS bf16_t* Hc = (LAS bf16_t*)lds;
#pragma unroll
    for (int r = 0; r < 4; ++r) { const float x = acc[r]; const float u = 0.7978845608028654f * (x + 0.044715f * x * x * x); const float th = 1.0f - 2.0f / (1.0f + __expf(2.0f * u)); Hc[(4 * hq + r) * 136 + 16 * w + c16] = (bf16_t)f2bf(0.5f * x * (1.0f + th)); }
    WG_SYNC();
    if (w < 4) {
        f32x4 o = {0.f, 0.f, 0.f, 0.f};
#pragma unroll
        for (int ks = 0; ks < 4; ++ks) o = mfma16(ldsv(lds + (c16 * 136 + 32 * ks + 8 * hq) * 2), gldv(W2 + (size_t)(16 * w + c16) * 128 + 32 * ks + 8 * hq), o);
        bf16_t* dst = (jk ? VC : KC) + (size_t)((b * 2 + g) * 256 + mt * 16) * 64;
#pragma unroll
        for (int r = 0; r < 4; ++r) dst[(4 * hq + r) * 64 + 16 * w + c16] = (bf16_t)f2bf(o[r]);
    }
    WG_SYNC();
}

struct MlBuf { bf16_t* U; float* NH; float* AC; float* BL; float* MC; };

__device__ __forceinline__ void mlstmA_unit(const KArgs& a, int j, LAS uchar* lds, int unit, const bf16_t* Z, const MlBuf& mb) {
    const int tid = opaque_tid(), lane = tid & 63, w = __builtin_amdgcn_readfirstlane(tid >> 6), c16 = lane & 15, hq = lane >> 4;
    const int bh = unit >> 6, c = unit & 63, b = bh >> 2, h = bh & 3;
    constexpr int KI = 0, VW = 17408, GA = 36864, GX = 37120, CW = 37376;
    LAS float* gA = (LAS float*)(lds + GA); LAS float* gX = (LAS float*)(lds + GX); LAS float* cwL = (LAS float*)(lds + CW);
    const float* cw = (const float*)a.in[4] + (size_t)j * 4 * 1024;
    { const int tap = tid >> 7, ch = tid & 127; cwL[tid] = cw[tap * 1024 + 512 + h * 128 + ch]; }
    const int t = tid >> 3, cg8 = tid & 7;
    if (w == 0) {
        const size_t row = (size_t)(b * T + c * 64 + lane);
        const float ig = bf2f(Z[row * ZE + C_AI + h]) + ((const float*)a.in[5])[j * 4 + h], fg = bf2f(Z[row * ZE + C_AF + h]) + ((const float*)a.in[6])[j * 4 + h];
        const float lf = fminf(fg, 0.f) - log1pf(__expf(-fabsf(fg)));
        float bs = lf;
#pragma unroll
        for (int o = 1; o < 64; o <<= 1) { const float t2 = __shfl_up(bs, o); if (lane >= o) bs += t2; }
        const float av = ig - bs; float mx = av;
#pragma unroll
        for (int o = 32; o; o >>= 1) mx = fmaxf(mx, __shfl_xor(mx, o));
        gA[lane] = av; if (lane == 63) { gX[0] = mx; gX[1] = bs; mb.AC[bh * 64 + c] = mx; mb.BL[bh * 64 + c] = bs; }
    }
    u32x4 xz[2][4];
#pragma unroll
    for (int g2 = 0; g2 < 2; ++g2)
#pragma unroll
        for (int tap = 0; tap < 4; ++tap) { const int tt = c * 64 + t - 3 + tap; xz[g2][tap] = (u32x4){0u, 0u, 0u, 0u}; if (tt >= 0) xz[g2][tap] = *(const u32x4*)(Z + (size_t)(b * T + tt) * ZE + C_AK + h * 128 + g2 * 64 + cg8 * 8); }
    const u32x4 v0 = *(const u32x4*)(Z + (size_t)(b * T + c * 64 + t) * ZE + C_AV + h * 128 + cg8 * 16), v1 = *(const u32x4*)(Z + (size_t)(b * T + c * 64 + t) * ZE + C_AV + h * 128 + cg8 * 16 + 8);
    WG_SYNC();
#pragma unroll
    for (int g2 = 0; g2 < 2; ++g2) {
        const int d = g2 * 64 + cg8 * 8; float acc[8];
#pragma unroll
        for (int i = 0; i < 8; ++i) acc[i] = 0.f;
#pragma unroll
        for (int tap = 0; tap < 4; ++tap) { const u32x4 x = xz[g2][tap]; const f32x4 w0 = *(const LAS f32x4*)(cwL + tap * 128 + d), w1 = *(const LAS f32x4*)(cwL + tap * 128 + d + 4);
            acc[0] += w0[0] * bflo(x.x); acc[1] += w0[1] * bfhi(x.x); acc[2] += w0[2] * bflo(x.y); acc[3] += w0[3] * bfhi(x.y);
            acc[4] += w1[0] * bflo(x.z); acc[5] += w1[1] * bfhi(x.z); acc[6] += w1[2] * bflo(x.w); acc[7] += w1[3] * bfhi(x.w); }
#pragma unroll
        for (int i = 0; i < 8; ++i) acc[i] = acc[i] * sigmoidf_(acc[i]);
        u32x4 o; o.x = pk2(acc[0], acc[1]); o.y = pk2(acc[2], acc[3]); o.z = pk2(acc[4], acc[5]); o.w = pk2(acc[6], acc[7]);
        *(LAS u32x4*)(lds + KI + t * 272 + d * 2) = o;
    }
    {   const float ws = __expf(gA[t] - gX[0]);
        u32x4 o0, o1;
        o0.x = pk2(bflo(v0.x) * ws, bfhi(v0.x) * ws); o0.y = pk2(bflo(v0.y) * ws, bfhi(v0.y) * ws); o0.z = pk2(bflo(v0.z) * ws, bfhi(v0.z) * ws); o0.w = pk2(bflo(v0.w) * ws, bfhi(v0.w) * ws);
        o1.x = pk2(bflo(v1.x) * ws, bfhi(v1.x) * ws); o1.y = pk2(bflo(v1.y) * ws, bfhi(v1.y) * ws); o1.z = pk2(bflo(v1.z) * ws, bfhi(v1.z) * ws); o1.w = pk2(bflo(v1.w) * ws, bfhi(v1.w) * ws);
        *(LAS u32x4*)(lds + VW + t * 304 + cg8 * 32) = o0; *(LAS u32x4*)(lds + VW + t * 304 + cg8 * 32 + 16) = o1;
        if (cg8 == 0) { unsigned zero = 0u; asm volatile("" : "+v"(zero)); u32x4 e; e.x = pk2(ws, 0.f); e.y = zero; e.z = zero; e.w = zero; u32x4 z4; z4.x = zero; z4.y = zero; z4.z = zero; z4.w = zero;
            *(LAS u32x4*)(lds + VW + t * 304 + 256) = e; *(LAS u32x4*)(lds + VW + t * 304 + 272) = z4; } }
    WG_SYNC();
    f32x4 acc[9];
#pragma unroll
    for (int vt = 0; vt < 9; ++vt) acc[vt] = (f32x4){0.f, 0.f, 0.f, 0.f};
#pragma unroll
    for (int ks = 0; ks < 2; ++ks) {
        const int r0 = 32 * ks + 4 * hq + (c16 >> 2), cofs = 4 * (c16 & 3);
        const bf16x8 A = cat4(tr16(lds + KI + r0 * 272 + (16 * w + cofs) * 2), tr16(lds + KI + (r0 + 16) * 272 + (16 * w + cofs) * 2));
#pragma unroll
        for (int vt = 0; vt < 9; ++vt) { const bf16x8 B = cat4(tr16(lds + VW + r0 * 304 + (16 * vt + cofs) * 2), tr16(lds + VW + (r0 + 16) * 304 + (16 * vt + cofs) * 2)); acc[vt] = mfma16(A, B, acc[vt]); }
    }
    bf16_t* U = mb.U + (size_t)(bh * 64 + c) * 16384;
#pragma unroll
    for (int vt = 0; vt < 8; ++vt) { u32x2 wv; wv.x = pk2(acc[vt][0], acc[vt][1]); wv.y = pk2(acc[vt][2], acc[vt][3]); *(u32x2*)(U + (size_t)(16 * vt + c16) * 128 + 16 * w + 4 * hq) = wv; }
    if (c16 == 0) *(f32x4*)(mb.NH + (size_t)(bh * 64 + c) * 128 + 16 * w + 4 * hq) = acc[8];
    WG_SYNC();
}

__device__ __forceinline__ void mlstm_scan(const MlBuf& mb) {
    const int tid = opaque_tid(); const int gid = blockIdx.x * NTHR + tid, nthr = gridDim.x * NTHR;
    for (int e = gid; e < 32 * 4096; e += nthr) {
        const int bh = e >> 12, eg = e & 4095;
        bf16_t* U = mb.U + (size_t)bh * 64 * 16384 + eg * 4;
        float st[4] = {0.f, 0.f, 0.f, 0.f}, sn[4] = {0.f, 0.f, 0.f, 0.f}, m = 0.f;
        for (int c0 = 0; c0 < 64; c0 += 8) {
            u32x2 u[8]; f32x4 nh[8]; float Ac[8], Bl[8];
#pragma unroll
            for (int k = 0; k < 8; ++k) { u[k] = *(const u32x2*)(U + (size_t)(c0 + k) * 16384); Ac[k] = mb.AC[bh * 64 + c0 + k]; Bl[k] = mb.BL[bh * 64 + c0 + k];
                nh[k] = (f32x4){0.f, 0.f, 0.f, 0.f}; if (eg < 32) nh[k] = *(const f32x4*)(mb.NH + (size_t)(bh * 64 + c0 + k) * 128 + eg * 4); }
#pragma unroll
            for (int k = 0; k < 8; ++k) {
                u32x2 o; o.x = pk2(st[0], st[1]); o.y = pk2(st[2], st[3]); *(u32x2*)(U + (size_t)(c0 + k) * 16384) = o;
                if (eg < 32) *(f32x4*)(mb.NH + (size_t)(bh * 64 + c0 + k) * 128 + eg * 4) = (f32x4){sn[0], sn[1], sn[2], sn[3]};
                if (eg == 0) mb.MC[bh * 64 + c0 + k] = m;
                const float Mx = fmaxf(m, Ac[k]), e1 = __expf(m - Mx), e2 = __expf(Ac[k] - Mx);
                st[0] = e1 * st[0] + e2 * bflo(u[k].x); st[1] = e1 * st[1] + e2 * bfhi(u[k].x); st[2] = e1 * st[2] + e2 * bflo(u[k].y); st[3] = e1 * st[3] + e2 * bfhi(u[k].y);
#pragma unroll
                for (int i = 0; i < 4; ++i) sn[i] = e1 * sn[i] + e2 * nh[k][i];
                m = Bl[k] + Mx;
            }
        }
    }
}

__device__ __forceinline__ void mlstmC_unit(const KArgs& a, int j, LAS uchar* lds, int unit, const bf16_t* Z, bf16_t* Y, const MlBuf& mb) {
    const int tid = opaque_tid(), lane = tid & 63, w = __builtin_amdgcn_readfirstlane(tid >> 6), c16 = lane & 15, hq = lane >> 4;
    GAS const bf16_t* Zg = (GAS const bf16_t*)Z; GAS bf16_t* Yg = (GAS bf16_t*)Y;
    const int bh = unit >> 6, c = unit & 63, b = bh >> 2, h = bh & 3;
    constexpr int QI = 0, KI = 17408, VN = 34816, SG = 54272, HC = 63488, GA = 97280, GM = 97536, GB = 97792, CW = 98304;
    LAS float* gA = (LAS float*)(lds + GA); LAS float* gM = (LAS float*)(lds + GM); LAS float* gB = (LAS float*)(lds + GB); LAS float* cwL = (LAS float*)(lds + CW);
    LAS float* hcL = (LAS float*)(lds + HC);
    const float* cw = (const float*)a.in[4] + (size_t)j * 4 * 1024;
    for (int i = tid; i < 1024; i += NTHR) { const int tap = i >> 8, ch = i & 255; cwL[i] = cw[tap * 1024 + (ch >> 7) * 512 + h * 128 + (ch & 127)]; }
    const float m_c = mb.MC[bh * 64 + c];
    const int t = tid >> 3, cg8 = tid & 7;
    if (w == 0) {
        const size_t row = (size_t)(b * T + c * 64 + lane);
        const float ig = bf2f(Zg[row * ZE + C_AI + h]) + ((const float*)a.in[5])[j * 4 + h], fg = bf2f(Zg[row * ZE + C_AF + h]) + ((const float*)a.in[6])[j * 4 + h];
        const float lf = fminf(fg, 0.f) - log1pf(__expf(-fabsf(fg)));
        float bs = lf;
#pragma unroll
        for (int o = 1; o < 64; o <<= 1) { const float t2 = __shfl_up(bs, o); if (lane >= o) bs += t2; }
        const float av = ig - bs; float pm = av;
#pragma unroll
        for (int o = 1; o < 64; o <<= 1) { const float t2 = __shfl_up(pm, o); if (lane >= o) pm = fmaxf(pm, t2); }
        gA[lane] = av; gM[lane] = fmaxf(m_c, pm); gB[lane] = bs;
    }
    u32x4 xz[4][4];
#pragma unroll
    for (int g4 = 0; g4 < 4; ++g4) { const int ch = g4 * 64 + cg8 * 8, zc = ((ch >> 7) ? C_AK : C_AQ) + h * 128 + (ch & 127);
#pragma unroll
        for (int tap = 0; tap < 4; ++tap) { const int tt = c * 64 + t - 3 + tap; xz[g4][tap] = (u32x4){0u, 0u, 0u, 0u}; if (tt >= 0) xz[g4][tap] = *(GAS const u32x4*)(Zg + (size_t)(b * T + tt) * ZE + zc); } }
    {   GAS const bf16_t* vp = Zg + (size_t)(b * T + c * 64 + t) * ZE + C_AV + h * 128 + cg8 * 16;
        *(LAS u32x4*)(lds + VN + t * 304 + cg8 * 32) = *(GAS const u32x4*)vp; *(LAS u32x4*)(lds + VN + t * 304 + cg8 * 32 + 16) = *(GAS const u32x4*)(vp + 8);
        if (cg8 == 0) { unsigned one = 0x3F80u, zero = 0u; asm volatile("" : "+v"(one), "+v"(zero)); u32x4 e; e.x = one; e.y = zero; e.z = zero; e.w = zero; u32x4 z4; z4.x = zero; z4.y = zero; z4.z = zero; z4.w = zero;
            *(LAS u32x4*)(lds + VN + t * 304 + 256) = e; *(LAS u32x4*)(lds + VN + t * 304 + 272) = z4; } }
    WG_SYNC();
#pragma unroll
    for (int g4 = 0; g4 < 4; ++g4) {
        const int ch = g4 * 64 + cg8 * 8, isk = ch >> 7, d = ch & 127; float acc[8];
#pragma unroll
        for (int i = 0; i < 8; ++i) acc[i] = 0.f;
#pragma unroll
        for (int tap = 0; tap < 4; ++tap) { const u32x4 x = xz[g4][tap]; const f32x4 w0 = *(const LAS f32x4*)(cwL + tap * 256 + ch), w1 = *(const LAS f32x4*)(cwL + tap * 256 + ch + 4);
            acc[0] += w0[0] * bflo(x.x); acc[1] += w0[1] * bfhi(x.x); acc[2] += w0[2] * bflo(x.y); acc[3] += w0[3] * bfhi(x.y);
            acc[4] += w1[0] * bflo(x.z); acc[5] += w1[1] * bfhi(x.z); acc[6] += w1[2] * bflo(x.w); acc[7] += w1[3] * bfhi(x.w); }
        const float sc = isk ? 1.0f : 0.08838834764831845f;
#pragma unroll
        for (int i = 0; i < 8; ++i) acc[i] = acc[i] * sigmoidf_(acc[i]) * sc;
        u32x4 o; o.x = pk2(acc[0], acc[1]); o.y = pk2(acc[2], acc[3]); o.z = pk2(acc[4], acc[5]); o.w = pk2(acc[6], acc[7]);
        *(LAS u32x4*)(lds + (isk ? KI : QI) + t * 272 + d * 2) = o;
    }
    WG_SYNC();
    {
        const int ti = w >> 1;
#pragma unroll
        for (int sjj = 0; sjj < 2; ++sjj) {
            const int sj = (w & 1) * 2 + sjj; f32x4 acc = {0.f, 0.f, 0.f, 0.f};
            if (sj <= ti) {
#pragma unroll
                for (int ks = 0; ks < 4; ++ks) acc = mfma16(ldsv(lds + QI + (16 * ti + c16) * 272 + (32 * ks + 8 * hq) * 2), ldsv(lds + KI + (16 * sj + c16) * 272 + (32 * ks + 8 * hq) * 2), acc);
            }
            const int s = 16 * sj + c16; const float as = gA[s];
#pragma unroll
            for (int r = 0; r < 4; ++r) { const int tt = 16 * ti + 4 * hq + r; const float val = (s <= tt) ? acc[r] * __expf(as - gM[tt]) : 0.f; ((LAS bf16_t*)(lds + SG))[tt * 72 + s] = (bf16_t)f2bf(val); }
        }
    }
    WG_SYNC();
    {
        const int tt = w & 3, vh = w >> 2;
        GAS const bf16_t* Cg = (GAS const bf16_t*)mb.U + (size_t)(bh * 64 + c) * 16384; GAS const float* ng = (GAS const float*)mb.NH + (size_t)(bh * 64 + c) * 128;
        f32x4 n[4], nd = {0.f, 0.f, 0.f, 0.f};
#pragma unroll
        for (int v4 = 0; v4 < 4; ++v4) n[v4] = (f32x4){0.f, 0.f, 0.f, 0.f};
#pragma unroll
        for (int ks = 0; ks < 4; ++ks) { const bf16x8 A = ldsv(lds + QI + (16 * tt + c16) * 272 + (32 * ks + 8 * hq) * 2);
#pragma unroll
            for (int v4 = 0; v4 < 4; ++v4) n[v4] = mfma16(A, gldvg(Cg + (size_t)(16 * (4 * vh + v4) + c16) * 128 + 32 * ks + 8 * hq), n[v4]);
            u32x4 nb = {0u, 0u, 0u, 0u};
            if (c16 == 0) { const f32x4 n0 = *(GAS const f32x4*)(ng + 32 * ks + 8 * hq), n1 = *(GAS const f32x4*)(ng + 32 * ks + 8 * hq + 4); nb.x = pk2(n0[0], n0[1]); nb.y = pk2(n0[2], n0[3]); nb.z = pk2(n1[0], n1[1]); nb.w = pk2(n1[2], n1[3]); }
            nd = mfma16(A, __builtin_bit_cast(bf16x8, nb), nd); }
#pragma unroll
        for (int r = 0; r < 4; ++r) { const float e = __expf(m_c - gM[16 * tt + 4 * hq + r]);
#pragma unroll
            for (int v4 = 0; v4 < 4; ++v4) n[v4][r] *= e;
            nd[r] *= e; }
#pragma unroll
        for (int ks = 0; ks < 2; ++ks) {
            const bf16x8 A = cat4(*(const LAS s16x4*)(lds + SG + (16 * tt + c16) * 144 + (32 * ks + 4 * hq) * 2), *(const LAS s16x4*)(lds + SG + (16 * tt + c16) * 144 + (32 * ks + 16 + 4 * hq) * 2));
            const int r0 = 32 * ks + 4 * hq + (c16 >> 2), cofs = 4 * (c16 & 3);
#pragma unroll
            for (int v4 = 0; v4 < 4; ++v4) { const int vt = 4 * vh + v4; n[v4] = mfma16(A, cat4(tr16(lds + VN + r0 * 304 + (16 * vt + cofs) * 2), tr16(lds + VN + (r0 + 16) * 304 + (16 * vt + cofs) * 2)), n[v4]); }
            nd = mfma16(A, cat4(tr16(lds + VN + r0 * 304 + (128 + cofs) * 2), tr16(lds + VN + (r0 + 16) * 304 + (128 + cofs) * 2)), nd); }
#pragma unroll
        for (int r = 0; r < 4; ++r) { const int tr_ = 16 * tt + 4 * hq + r; const float den = __shfl(nd[r], lane & 48); const float lim = __expf(-(gB[tr_] + gM[tr_]));
            const float dv = 1.0f / fmaxf(fabsf(den), lim);
#pragma unroll
            for (int v4 = 0; v4 < 4; ++v4) hcL[tr_ * 132 + 16 * (4 * vh + v4) + c16] = n[v4][r] * dv; }
    }
    WG_SYNC();
    {
        const size_t row = (size_t)(b * T + c * 64 + t);
        float x[16]; float s = 0.f;
#pragma unroll
        for (int i = 0; i < 4; ++i) { const f32x4 v = *(const LAS f32x4*)(hcL + t * 132 + cg8 * 16 + 4 * i); x[4 * i] = v[0]; x[4 * i + 1] = v[1]; x[4 * i + 2] = v[2]; x[4 * i + 3] = v[3]; s += (v[0] + v[1]) + (v[2] + v[3]); }
        s += __shfl_xor(s, 1); s += __shfl_xor(s, 2); s += __shfl_xor(s, 4);
        const float mu = s * (1.0f / 128.0f); float q = 0.f;
#pragma unroll
        for (int i = 0; i < 16; ++i) { x[i] -= mu; q += x[i] * x[i]; }
        q += __shfl_xor(q, 1); q += __shfl_xor(q, 2); q += __shfl_xor(q, 4);
        const float rs = rsqrtf(q * (1.0f / 128.0f) + LN_EPS);
        const float* ng = (const float*)a.in[7] + (size_t)j * 512 + h * 128 + cg8 * 16;
        const u32x4 o0 = *(GAS const u32x4*)(Zg + row * ZE + C_AO + h * 128 + cg8 * 16), o1 = *(GAS const u32x4*)(Zg + row * ZE + C_AO + h * 128 + cg8 * 16 + 8);
        const float ov[16] = {bflo(o0.x), bfhi(o0.x), bflo(o0.y), bfhi(o0.y), bflo(o0.z), bfhi(o0.z), bflo(o0.w), bfhi(o0.w), bflo(o1.x), bfhi(o1.x), bflo(o1.y), bfhi(o1.y), bflo(o1.z), bfhi(o1.z), bflo(o1.w), bfhi(o1.w)};
        float y[16];
#pragma unroll
        for (int i = 0; i < 16; ++i) y[i] = x[i] * rs * ng[i] * sigmoidf_(ov[i]);
        u32x4 w0, w1; w0.x = pk2(y[0], y[1]); w0.y = pk2(y[2], y[3]); w0.z = pk2(y[4], y[5]); w0.w = pk2(y[6], y[7]); w1.x = pk2(y[8], y[9]); w1.y = pk2(y[10], y[11]); w1.z = pk2(y[12], y[13]); w1.w = pk2(y[14], y[15]);
        *(GAS u32x4*)(Yg + row * D + h * 128 + cg8 * 16) = w0; *(GAS u32x4*)(Yg + row * D + h * 128 + cg8 * 16 + 8) = w1;
    }
    WG_SYNC();
}

__device__ __forceinline__ void stage64(LAS uchar* dst, const bf16_t* src, size_t ld) { const int tid = opaque_tid(), row = tid >> 3, ch = tid & 7; *(LAS u32x4*)(dst + row * 144 + ch * 16) = *(const u32x4*)(src + (size_t)row * ld + ch * 8); }

template <int MODE>
__device__ __forceinline__ void nsa_tile(LAS const uchar* Kt, LAS const uchar* Vt, const bf16x8 (&qf)[2][2], float (&mr)[2], float (&lr)[2], f32x4 (&o)[2][4],
                                         int tile, const int (&tq)[2], const unsigned (&selw)[2], LAS float* IMP, int w, int lane) {
    const int c16 = lane & 15, hq = lane >> 4;
    if (MODE == 2) { if (__ballot((selw[0] | selw[1]) != 0u) == 0ull) return; }
    f32x4 s[2][4];
#pragma unroll
    for (int kt = 0; kt < 4; ++kt) { const bf16x8 A0 = ldsv(Kt + (16 * kt + c16) * 144 + 16 * hq), A1 = ldsv(Kt + (16 * kt + c16) * 144 + 64 + 16 * hq);
#pragma unroll
        for (int qt = 0; qt < 2; ++qt) { f32x4 z = {0.f, 0.f, 0.f, 0.f}; z = mfma16(A0, qf[qt][0], z); s[qt][kt] = mfma16(A1, qf[qt][1], z); } }
#pragma unroll
    for (int qt = 0; qt < 2; ++qt) {
        unsigned vm = 0; float mx = NEGF;
        const int tqlo = (tq[qt] & ~63) + 8 * w, tqhi = tqlo + 7;
        bool full = false;
        if (MODE == 2) full = (tile * 64 + 63 <= tqlo);
        if (MODE == 3) full = (tile * 64 + 63 <= tqlo) && (tile * 64 > tqhi - 512);
        if (full) {
            vm = (MODE == 2) ? (selw[qt] ? 0xFFFFu : 0u) : 0xFFFFu;
            if (vm) {
#pragma unroll
                for (int kt = 0; kt < 4; ++kt) mx = fmaxf(fmaxf(mx, fmaxf(s[qt][kt][0], s[qt][kt][1])), fmaxf(s[qt][kt][2], s[qt][kt][3])); }
        } else {
#pragma unroll
        for (int kt = 0; kt < 4; ++kt)
#pragma unroll
            for (int r = 0; r < 4; ++r) { const int key = tile * 64 + 16 * kt + 4 * hq + r; bool v;
                if (MODE <= 1) v = (16 * key + 31 <= tq[qt]) && (key < 255);
                else if (MODE == 2) v = (selw[qt] != 0u) && (key <= tq[qt]);
                else v = (key <= tq[qt]) && (key > tq[qt] - 512);
                if (v) { vm |= 1u << (kt * 4 + r); mx = fmaxf(mx, s[qt][kt][r]); } }
        }
        if (MODE != 1) {
            mx = fmaxf(mx, __shfl_xor(mx, 16)); mx = fmaxf(mx, __shfl_xor(mx, 32));
            const float mnew = fmaxf(mr[qt], mx), alpha = __expf(mr[qt] - mnew); float sum = 0.f;
#pragma unroll
            for (int kt = 0; kt < 4; ++kt)
#pragma unroll
                for (int r = 0; r < 4; ++r) { const float p = ((vm >> (kt * 4 + r)) & 1u) ? __expf(s[qt][kt][r] - mnew) : 0.f; s[qt][kt][r] = p; sum += p; }
            sum += __shfl_xor(sum, 16); sum += __shfl_xor(sum, 32);
            lr[qt] = lr[qt] * alpha + sum; mr[qt] = mnew;
            if (MODE != 0) {
#pragma unroll
                for (int dt = 0; dt < 4; ++dt) o[qt][dt] = o[qt][dt] * alpha; }
        } else {
            const float mfin = mr[qt], inv = lr[qt] > 0.f ? 1.0f / lr[qt] : 0.f;
#pragma unroll
            for (int kt = 0; kt < 4; ++kt) {
#pragma unroll
                for (int r = 0; r < 4; ++r) s[qt][kt][r] = ((vm >> (kt * 4 + r)) & 1u) ? __expf(s[qt][kt][r] - mfin) * inv : 0.f;
                float own = (s[qt][kt][0] + s[qt][kt][1]) + (s[qt][kt][2] + s[qt][kt][3]), nb = s[qt][kt][3];
                own += __shfl_xor(own, 1); own += __shfl_xor(own, 2); nb += __shfl_xor(nb, 1); nb += __shfl_xor(nb, 2);
                if ((c16 & 3) == 0) { const int q = 8 * w + 4 * qt + (c16 >> 2), jb = 16 * tile + 4 * kt + hq;
                    __hip_atomic_fetch_add(IMP + q * 64 + jb, own, __ATOMIC_RELAXED, __HIP_MEMORY_SCOPE_WORKGROUP);
                    if (jb < 63) __hip_atomic_fetch_add(IMP + q * 64 + jb + 1, nb, __ATOMIC_RELAXED, __HIP_MEMORY_SCOPE_WORKGROUP); }
            }
        }
    }
    if (MODE != 0) {
#pragma unroll
        for (int k2 = 0; k2 < 2; ++k2) {
            bf16x8 B[2];
#pragma unroll
            for (int qt = 0; qt < 2; ++qt) B[qt] = pack8(s[qt][2 * k2], s[qt][2 * k2 + 1]);
#pragma unroll
            for (int dt = 0; dt < 4; ++dt) {
                const s16x4 lo = tr16(Vt + (32 * k2 + 4 * hq + (c16 >> 2)) * 144 + (16 * dt + 4 * (c16 & 3)) * 2), hi = tr16(Vt + (32 * k2 + 16 + 4 * hq + (c16 >> 2)) * 144 + (16 * dt + 4 * (c16 & 3)) * 2);
                const bf16x8 A = cat4(lo, hi);
#pragma unroll
                for (int qt = 0; qt < 2; ++qt) o[qt][dt] = mfma16(A, B[qt], o[qt][dt]);
            }
        }
    }
}

template <int MODE>
__device__ __forceinline__ void nsa_sweep(LAS uchar* lds, unsigned long long msk, const bf16_t* Kb, const bf16_t* Vb, size_t step, size_t ld,
                                          const bf16x8 (&qf)[2][2], float (&mr)[2], float (&lr)[2], f32x4 (&o)[2][4], const int (&tq)[2], LAS const unsigned* SELM, LAS float* IMP, int w, int lane) {
    const int tid = opaque_tid(), row = tid >> 3, ch = tid & 7, c16 = lane & 15;
    if (msk == 0ull) return;
    GAS const bf16_t* Kg = (GAS const bf16_t*)Kb; GAS const bf16_t* Vg = (GAS const bf16_t*)Vb;
    constexpr int K0 = 0, V0 = 9216, K1 = 36864, V1 = 46080;
    int t0 = __ffsll((long long)msk) - 1; msk &= msk - 1ull;
    int t1 = msk ? (__ffsll((long long)msk) - 1) : -1; if (t1 >= 0) msk &= msk - 1ull;
    u32x4 rk0 = *(GAS const u32x4*)(Kg + (size_t)t0 * step + (size_t)row * ld + ch * 8), rv0 = rk0, rk1 = rk0, rv1 = rk0;
    if (MODE != 0) rv0 = *(GAS const u32x4*)(Vg + (size_t)t0 * step + (size_t)row * ld + ch * 8);
    if (t1 >= 0) { rk1 = *(GAS const u32x4*)(Kg + (size_t)t1 * step + (size_t)row * ld + ch * 8); if (MODE != 0) rv1 = *(GAS const u32x4*)(Vg + (size_t)t1 * step + (size_t)row * ld + ch * 8); }
    while (true) {
        *(LAS u32x4*)(lds + K0 + row * 144 + ch * 16) = rk0; if (MODE != 0) *(LAS u32x4*)(lds + V0 + row * 144 + ch * 16) = rv0;
        if (t1 >= 0) { *(LAS u32x4*)(lds + K1 + row * 144 + ch * 16) = rk1; if (MODE != 0) *(LAS u32x4*)(lds + V1 + row * 144 + ch * 16) = rv1; }
        int n0 = -1, n1 = -1;
        if (msk) { n0 = __ffsll((long long)msk) - 1; msk &= msk - 1ull; if (msk) { n1 = __ffsll((long long)msk) - 1; msk &= msk - 1ull; } }
        unsigned sa[2] = {0u, 0u}, sb[2] = {0u, 0u};
        if (MODE == 2) {
#pragma unroll
            for (int qt = 0; qt < 2; ++qt) { const int q = 8 * w + 4 * qt + (c16 >> 2); sa[qt] = (SELM[q * 2 + (t0 >> 5)] >> (t0 & 31)) & 1u; if (t1 >= 0) sb[qt] = (SELM[q * 2 + (t1 >> 5)] >> (t1 & 31)) & 1u; } }
        WG_SYNC();
        if (n0 >= 0) { rk0 = *(GAS const u32x4*)(Kg + (size_t)n0 * step + (size_t)row * ld + ch * 8); if (MODE != 0) rv0 = *(GAS const u32x4*)(Vg + (size_t)n0 * step + (size_t)row * ld + ch * 8); }
        if (n1 >= 0) { rk1 = *(GAS const u32x4*)(Kg + (size_t)n1 * step + (size_t)row * ld + ch * 8); if (MODE != 0) rv1 = *(GAS const u32x4*)(Vg + (size_t)n1 * step + (size_t)row * ld + ch * 8); }
        nsa_tile<MODE>(lds + K0, lds + V0, qf, mr, lr, o, t0, tq, sa, IMP, w, lane);
        if (t1 >= 0) nsa_tile<MODE>(lds + K1, lds + V1, qf, mr, lr, o, t1, tq, sb, IMP, w, lane);
        WG_SYNC();
        if (n0 < 0) break;
        t0 = n0; t1 = n1;
    }
}

__device__ __forceinline__ void nsa_unit(const KArgs& a, int j, LAS uchar* lds, int b, int g, int qb, const bf16_t* Z, const bf16_t* KC, const bf16_t* VC, bf16_t* Y) {
    const int tid = opaque_tid(), lane = tid & 63, w = __builtin_amdgcn_readfirstlane(tid >> 6), c16 = lane & 15, hq = lane >> 4;
    constexpr int KT_ = 0, VT_ = 9216, IMP_ = 18432, SEL_ = 34816, ANY_ = 35328;
    LAS float* IMP = (LAS float*)(lds + IMP_); LAS unsigned* SELM = (LAS unsigned*)(lds + SEL_); LAS unsigned* ANY = (LAS unsigned*)(lds + ANY_);
    GAS const bf16_t* Zg = (GAS const bf16_t*)Z; GAS bf16_t* Yg = (GAS bf16_t*)Y;
    const int s0 = qb * 64, head = c16 & 3;
    int tq[2]; bf16x8 qf[2][2]; float gt[2][3];
#pragma unroll
    for (int qt = 0; qt < 2; ++qt) {
        tq[qt] = s0 + 8 * w + 4 * qt + (c16 >> 2);
        const size_t row = (size_t)(b * T + tq[qt]);
#pragma unroll
        for (int ks = 0; ks < 2; ++ks) { const u32x4 x = *(GAS const u32x4*)(Zg + row * ZE + C_BQ + (g * 4 + head) * 64 + 32 * ks + 8 * hq);
            u32x4 y; y.x = pk2(bflo(x.x) * 0.125f, bfhi(x.x) * 0.125f); y.y = pk2(bflo(x.y) * 0.125f, bfhi(x.y) * 0.125f); y.z = pk2(bflo(x.z) * 0.125f, bfhi(x.z) * 0.125f); y.w = pk2(bflo(x.w) * 0.125f, bfhi(x.w) * 0.125f);
            qf[qt][ks] = __builtin_bit_cast(bf16x8, y); }
#pragma unroll
        for (int br = 0; br < 3; ++br) gt[qt][br] = sigmoidf_(bf2f(Zg[row * ZE + C_BG + g * 12 + head * 3 + br]) + ((const float*)a.in[11])[j * 24 + g * 12 + head * 3 + br]);
#ifdef PROBE_NSA_BR
        gt[qt][PROBE_NSA_BR] *= (float)(PROBE_NSA_BS);
#endif
    }
    for (int i = tid; i < 4096; i += NTHR) IMP[i] = 0.f;
    if (tid < 128) SELM[tid] = 0u; if (tid < 2) ANY[tid] = 0u;
    float mr[2] = {NEGF, NEGF}, lr[2] = {0.f, 0.f}; f32x4 o[2][4], ot[2][4]; unsigned selw[2] = {0u, 0u};
#pragma unroll
    for (int qt = 0; qt < 2; ++qt)
#pragma unroll
        for (int dt = 0; dt < 4; ++dt) { o[qt][dt] = (f32x4){0.f, 0.f, 0.f, 0.f}; ot[qt][dt] = o[qt][dt]; }
    const bf16_t* kc = KC + (size_t)(b * 2 + g) * 256 * 64; const bf16_t* vc = VC + (size_t)(b * 2 + g) * 256 * 64;
    int ntc = (s0 + 32) / 1024 + 1; if (ntc > 4) ntc = 4;
    WG_SYNC();
    nsa_sweep<0>(lds, (1ull << ntc) - 1ull, kc, vc, (size_t)64 * 64, 64, qf, mr, lr, o, tq, SELM, IMP, w, lane);
    nsa_sweep<1>(lds, (1ull << ntc) - 1ull, kc, vc, (size_t)64 * 64, 64, qf, mr, lr, o, tq, SELM, IMP, w, lane);
#pragma unroll
    for (int qt = 0; qt < 2; ++qt)
#pragma unroll
        for (int dt = 0; dt < 4; ++dt) { ot[qt][dt] = o[qt][dt] * gt[qt][0]; o[qt][dt] = (f32x4){0.f, 0.f, 0.f, 0.f}; }
    {
        const int q = tid >> 3, sub = tid & 7; unsigned bits = 0u;
        if (qb + 1 <= 16) { for (int jj = 0; jj < 8; ++jj) if (sub * 8 + jj <= qb) bits |= 1u << jj; }
        else {
            for (int jj = 0; jj < 8; ++jj) { const int jb = sub * 8 + jj; bool sel = (jb == 0) || (jb == qb) || (jb == qb - 1);
                if (!sel && jb >= 1 && jb <= qb - 2) { const float v = IMP[q * 64 + jb]; int cnt = 0;
                    for (int j2 = 1; j2 <= qb - 2; ++j2) { const float v2 = IMP[q * 64 + j2]; cnt += ((v2 > v) || (v2 == v && j2 < jb)) ? 1 : 0; }
                    sel = cnt < 13; }
                if (sel) bits |= 1u << jj; }
        }
        atomicOr((unsigned*)(SELM + q * 2 + (sub >> 2)), bits << ((sub & 3) * 8)); atomicOr((unsigned*)(ANY + (sub >> 2)), bits << ((sub & 3) * 8));
    }
    WG_SYNC();
    const unsigned any0 = ANY[0], any1 = ANY[1];
    mr[0] = mr[1] = NEGF; lr[0] = lr[1] = 0.f;
    {
        unsigned long long msk = ((unsigned long long)any1 << 32) | (unsigned long long)any0;
        msk &= (qb >= 63) ? ~0ull : ((1ull << (qb + 1)) - 1ull);
        nsa_sweep<2>(lds, msk, Z + (size_t)(b * T) * ZE + C_BKS + g * 64, Z + (size_t)(b * T) * ZE + C_BVS + g * 64, (size_t)64 * ZE, ZE, qf, mr, lr, o, tq, SELM, IMP, w, lane);
#ifdef PROBE_NSA_SEL
        { float mr2[2] = {NEGF, NEGF}, lr2[2] = {0.f, 0.f}; f32x4 o2[2][4];
          for (int qt = 0; qt < 2; ++qt) for (int dt = 0; dt < 4; ++dt) o2[qt][dt] = (f32x4){0.f, 0.f, 0.f, 0.f};
          nsa_sweep<2>(lds, msk, Z + (size_t)(b * T) * ZE + C_BKS + g * 64, Z + (size_t)(b * T) * ZE + C_BVS + g * 64, (size_t)64 * ZE, ZE, qf, mr2, lr2, o2, tq, SELM, IMP, w, lane);
          if (lr2[0] == -1.0f) ot[0][0] = o2[0][0]; }
#endif
    }
#pragma unroll
    for (int qt = 0; qt < 2; ++qt) { const float sc = lr[qt] > 0.f ? gt[qt][1] / lr[qt] : 0.f;
#pragma unroll
        for (int dt = 0; dt < 4; ++dt) { ot[qt][dt] = ot[qt][dt] + o[qt][dt] * sc; o[qt][dt] = (f32x4){0.f, 0.f, 0.f, 0.f}; } }
    mr[0] = mr[1] = NEGF; lr[0] = lr[1] = 0.f;
    {
        const int lo_t = qb > 8 ? qb - 8 : 0;
        unsigned long long msk = (qb >= 63) ? ~0ull : ((1ull << (qb + 1)) - 1ull);
        msk &= ~((1ull << lo_t) - 1ull);
        nsa_sweep<3>(lds, msk, Z + (size_t)(b * T) * ZE + C_BKW + g * 64, Z + (size_t)(b * T) * ZE + C_BVW + g * 64, (size_t)64 * ZE, ZE, qf, mr, lr, o, tq, SELM, IMP, w, lane);
    }
#pragma unroll
    for (int qt = 0; qt < 2; ++qt) { const float sc = lr[qt] > 0.f ? gt[qt][2] / lr[qt] : 0.f;
#pragma unroll
        for (int dt = 0; dt < 4; ++dt) { f32x4 v = ot[qt][dt] + o[qt][dt] * sc;
#ifdef PROBE_NSA_SCALE
            v = v * (float)(PROBE_NSA_SCALE);
#endif
            u32x2 wv; wv.x = pk2(v[0], v[1]); wv.y = pk2(v[2], v[3]);
            *(GAS u32x2*)(Yg + (size_t)(b * T + tq[qt]) * D + 512 + (g * 4 + head) * 64 + 16 * dt + 4 * hq) = wv; } }
    WG_SYNC();
}
#define XB_TMO      128
#define XB_XCNT(j)  (256  + 64 * (j))
#define XB_XSUB(j)  (1280 + 64 * (j))
#define XB_XGEN(j)  (2304 + 64 * (j))
#define XB_TOP      3328
#define XB_TOPGEN   3392
#define XCD_BAR_WORDS 3456
#define XB_SPIN_CAP (1u << 18)

__device__ __forceinline__ unsigned xb_ld(unsigned* p)              { return __hip_atomic_load(p, __ATOMIC_RELAXED, __HIP_MEMORY_SCOPE_AGENT); }
__device__ __forceinline__ unsigned xb_add(unsigned* p, unsigned v) { return __hip_atomic_fetch_add(p, v, __ATOMIC_RELAXED, __HIP_MEMORY_SCOPE_AGENT); }
__device__ __forceinline__ unsigned xb_xcc_id() { return (unsigned)__builtin_amdgcn_s_getreg((3 << 11) | 20) & 0xFu; }
#define XB_SPIN(cond, bar) do { unsigned _sp = 0; while (cond) { __builtin_amdgcn_s_sleep(1); \
    if ((++_sp & 255u) == 0u) { if (xb_ld(&(bar)[XB_TMO])) break; if (_sp > XB_SPIN_CAP) { atomicAdd(&(bar)[XB_TMO], 1u); break; } } } } while (0)

struct XcdBarrier {
    unsigned* bar; unsigned x;
    volatile LAS unsigned* st;
};

__device__ __forceinline__ XcdBarrier xcd_barrier_post(unsigned* bar, volatile LAS unsigned* st) {
    XcdBarrier b; b.bar = bar; b.x = xb_xcc_id(); b.st = st;
    if (threadIdx.x == 0) (void)xb_add(&bar[XB_XCNT(b.x)], 1u);
    return b;
}
__device__ __forceinline__ void xcd_barrier_complete(unsigned* bar, unsigned x, unsigned& nloc, unsigned& nx) {
    const unsigned G = gridDim.x * gridDim.y * gridDim.z;
    unsigned sum, cnt, mine, sp = 0u;
    for (;;) {
        sum = 0u; cnt = 0u; mine = 0u;
#pragma unroll
        for (unsigned j = 0; j < 16; ++j) { const unsigned c = xb_ld(&bar[XB_XCNT(j)]); sum += c; cnt += (c > 0u) ? 1u : 0u; mine = (j == x) ? c : mine; }
        if (sum == G) break;
        __builtin_amdgcn_s_sleep(1);
        if ((++sp & 255u) == 0u) { if (xb_ld(&bar[XB_TMO])) break; if (sp > XB_SPIN_CAP) { atomicAdd(&bar[XB_TMO], 1u); break; } }
    }
    nloc = mine > 0u ? mine : 1u; nx = cnt > 0u ? cnt : 1u;
}

__device__ __forceinline__ void xcd_barrier(const XcdBarrier& b) {
    asm volatile("s_waitcnt vmcnt(0)" ::: "memory");
    __syncthreads();
    if (threadIdx.x == 0) {
        unsigned* bar = b.bar; asm volatile("" : "+s"(bar));
        __builtin_amdgcn_s_waitcnt(0);
        unsigned nloc = b.st[0], nx = b.st[1];
        if (nloc == 0u) { xcd_barrier_complete(bar, b.x, nloc, nx); b.st[0] = nloc; b.st[1] = nx; }
        const unsigned old = xb_add(&bar[XB_XSUB(b.x)], 1u);
        const unsigned gen = old / nloc;
        if (old + 1u == (gen + 1u) * nloc) {
            __builtin_amdgcn_fence(__ATOMIC_RELEASE, "agent");
            asm volatile("s_waitcnt vmcnt(0)" ::: "memory");
            const unsigned og = xb_add(&bar[XB_TOP], 1u);
            const unsigned tg = og / nx;
            if (og + 1u == (tg + 1u) * nx) xb_add(&bar[XB_TOPGEN], 1u);
            else XB_SPIN(xb_ld(&bar[XB_TOPGEN]) == tg, bar);
            __builtin_amdgcn_fence(__ATOMIC_ACQUIRE, "agent");
            xb_add(&bar[XB_XGEN(b.x)], 1u);
            asm volatile("s_waitcnt vmcnt(0)" ::: "memory");
        } else {
            XB_SPIN(xb_ld(&bar[XB_XGEN(b.x)]) == gen, bar);
            __builtin_amdgcn_fence(__ATOMIC_ACQUIRE, "agent");
            asm volatile("s_waitcnt vmcnt(0)" ::: "memory");
        }
    }
    __syncthreads();
}

__device__ __forceinline__ void odd_prep(const KArgs& a, int j, const bf16_t* Z1, bf16_t* CQ, bf16_t* KV, bf16_t* KI, float* WI) {
    const int tid = opaque_tid(), lane = tid & 63, gw = blockIdx.x * 8 + (tid >> 6), nw = gridDim.x * 8;
    const int* pos = (const int*)a.in[2];
    const float* qn = (const float*)a.in[14] + (size_t)j * 512 + lane * 8; const float* kn = (const float*)a.in[15] + (size_t)j * 256 + lane * 4;
    const f32x4 qn0 = *(const f32x4*)qn, qn1 = *(const f32x4*)(qn + 4), kn0 = *(const f32x4*)kn;
    const float ikg = ((const float*)a.in[20])[j * 64 + lane], ikb = ((const float*)a.in[21])[j * 64 + lane];
    const float inv64 = exp2f(-(float)(lane & 31) * (13.287712379549449f * 2.0f / 64.0f)), inv32 = exp2f(-(float)(lane & 15) * (13.287712379549449f * 2.0f / 32.0f));
    for (int row = gw; row < M; row += nw) {
        const bf16_t* z = Z1 + (size_t)row * 1024; const float ps = (float)pos[row];
        {   const u32x4 x = *(const u32x4*)(z + lane * 8);
            float v[8] = {bflo(x.x), bfhi(x.x), bflo(x.y), bfhi(x.y), bflo(x.z), bfhi(x.z), bflo(x.w), bfhi(x.w)}; float q = 0.f;
#pragma unroll
            for (int i = 0; i < 8; ++i) q += v[i] * v[i];
            const float rs = rsqrtf(wave_sum(q) * (1.0f / 512.0f) + LN_EPS);
            u32x4 o; o.x = pk2(v[0] * rs * qn0[0], v[1] * rs * qn0[1]); o.y = pk2(v[2] * rs * qn0[2], v[3] * rs * qn0[3]); o.z = pk2(v[4] * rs * qn1[0], v[5] * rs * qn1[1]); o.w = pk2(v[6] * rs * qn1[2], v[7] * rs * qn1[3]);
            *(u32x4*)(CQ + (size_t)row * 512 + lane * 8) = o; }
        {   const u32x2 x = *(const u32x2*)(z + 512 + lane * 4);
            const float v0 = bflo(x.x), v1 = bfhi(x.x), v2 = bflo(x.y), v3 = bfhi(x.y);
            const float rs = rsqrtf(wave_sum(v0 * v0 + v1 * v1 + v2 * v2 + v3 * v3) * (1.0f / 256.0f) + LN_EPS);
            u32x2 o; o.x = pk2(v0 * rs * kn0[0], v1 * rs * kn0[1]); o.y = pk2(v2 * rs * kn0[2], v3 * rs * kn0[3]);
            *(u32x2*)(KV + (size_t)row * 320 + lane * 4) = o; }
        {   const float kr = bf2f(z[768 + lane]); const float other = __shfl_xor(kr, 32);
            float s, c; sincos_rev(ps * inv64, s, c);
            const float outv = lane < 32 ? (kr * c - other * s) : (other * s + kr * c);
            KV[(size_t)row * 320 + 256 + lane] = (bf16_t)f2bf(outv); }
        {   const float ik = bf2f(z[832 + lane]); const float mu = wave_sum(ik) * (1.0f / 64.0f); const float dlt = ik - mu;
            const float rs = rsqrtf(wave_sum(dlt * dlt) * (1.0f / 64.0f) + LN_EPS); const float kv = dlt * rs * ikg + ikb;
            const float other = __shfl_xor(kv, 16); float s, c; sincos_rev(ps * inv32, s, c);
            float outv = kv; if (lane < 16) outv = kv * c - other * s; else if (lane < 32) outv = other * s + kv * c;
            KI[(size_t)(row >> 4) * 1024 + (size_t)(((lane >> 5) * 4 + ((lane & 31) >> 3)) * 128 + (row & 15) * 8 + (lane & 7))] = (bf16_t)f2bf(outv); }
        if (lane < 8) WI[(size_t)row * 8 + lane] = bf2f(z[896 + lane]) * 0.044194173824159216f;
    }
}

template <bool DOSEL> __device__ __forceinline__ void indexer_unit(LAS uchar* lds, int b, int t0, const bf16_t* Q2_, const bf16_t* KI_, const float* WI_, unsigned short* IDX_) {
    GAS const bf16_t* Q2 = (GAS const bf16_t*)Q2_; GAS const bf16_t* KI = (GAS const bf16_t*)KI_; GAS const float* WI = (GAS const float*)WI_; GAS unsigned short* IDX = (GAS unsigned short*)IDX_;
    const int tid = opaque_tid(), lane = tid & 63, w = __builtin_amdgcn_readfirstlane(tid >> 6), c16 = lane & 15, hq = lane >> 4;
    LAS float* SC = (LAS float*)lds;
    bf16x8 af[4][2]; float wv[4][4];
#pragma unroll
    for (int rt = 0; rt < 4; ++rt) {
        const size_t rowA = (size_t)(b * T + t0 + 2 * rt + (c16 >> 3));
#pragma unroll
        for (int ks = 0; ks < 2; ++ks) af[rt][ks] = gldvg(Q2 + rowA * 3072 + 2560 + (c16 & 7) * 64 + 32 * ks + 8 * hq);
        const size_t rowC = (size_t)(b * T + t0 + 2 * rt + (hq >> 1));
        const f32x4 wf = *(GAS const f32x4*)(WI + rowC * 8 + 4 * (hq & 1));
#pragma unroll
        for (int r = 0; r < 4; ++r) wv[rt][r] = wf[r];
    }
    const int nkt = (t0 + 7) / 16 + 1;
    bf16x8 b0[4], b1[4];
#define IX_LOAD(G0) do { _Pragma("unroll") for (int u = 0; u < 4; ++u) { int kt = (G0) + u; if (kt > nkt - 1) kt = nkt - 1; GAS const bf16_t* kp = KI + (size_t)(b * (T / 16) + kt) * 1024 + hq * 128 + c16 * 8; b0[u] = gldvg(kp); b1[u] = gldvg(kp + 512); } } while (0)
    if (w * 4 < nkt) IX_LOAD(w * 4);
    for (int g0 = w * 4; g0 < nkt; g0 += 32) {
        bf16x8 c0[4], c1[4];
#pragma unroll
        for (int u = 0; u < 4; ++u) { c0[u] = b0[u]; c1[u] = b1[u]; }
        if (g0 + 32 < nkt) IX_LOAD(g0 + 32);
#pragma unroll
        for (int u = 0; u < 4; ++u) { const int kt = g0 + u;
            if (kt < nkt) {
#pragma unroll
                for (int rt = 0; rt < 4; ++rt) {
                    f32x4 acc = {0.f, 0.f, 0.f, 0.f}; acc = mfma16(af[rt][0], c0[u], acc); acc = mfma16(af[rt][1], c1[u], acc);
                    float part = wv[rt][0] * fmaxf(acc[0], 0.f) + wv[rt][1] * fmaxf(acc[1], 0.f) + wv[rt][2] * fmaxf(acc[2], 0.f) + wv[rt][3] * fmaxf(acc[3], 0.f);
                    part += __shfl_xor(part, 16);
                    if ((hq & 1) == 0) SC[(2 * rt + (hq >> 1)) * 4096 + 16 * kt + c16] = part;
                } } }
    }
#undef IX_LOAD
    WG_SYNC();
    if (DOSEL) {
        const int tq = t0 + w, n = tq + 1; GAS unsigned short* out = IDX + (size_t)(b * T + tq) * 256;
        if (n <= 256) {
#pragma unroll
            for (int i = 0; i < 4; ++i) { const int s = i * 64 + lane; out[s] = (unsigned short)(s < n ? s : 0xFFFF); }
        } else {
            const int ni = (n + 63) >> 6; unsigned key[64];
#pragma unroll
            for (int i = 0; i < 64; ++i) { const int s = i * 64 + lane; unsigned k = 0u;
                if (i < ni && s < n) { const float f = SC[w * 4096 + s] + 0.0f; const unsigned u = __float_as_uint(f); k = (u & 0x80000000u) ? ~u : (u | 0x80000000u); }
                key[i] = k; }
            LAS unsigned* hist = (LAS unsigned*)(lds + 131072 + w * 1024);
            unsigned prefix = 0u; int remaining = 256;
#pragma unroll 1
            for (int pass = 0; pass < 4; ++pass) {
                const int shift = 24 - 8 * pass;
#pragma unroll
                for (int z = 0; z < 4; ++z) hist[lane + 64 * z] = 0u;
                asm volatile("s_waitcnt lgkmcnt(0)" ::: "memory");
#pragma unroll
                for (int i = 0; i < 64; ++i) if (i < ni) { const unsigned k = key[i];
                    const bool in = (pass == 0) || (((k ^ prefix) >> (shift + 8)) == 0u);
                    if (in) __hip_atomic_fetch_add(hist + ((k >> shift) & 255u), 1u, __ATOMIC_RELAXED, __HIP_MEMORY_SCOPE_WORKGROUP); }
                asm volatile("s_waitcnt lgkmcnt(0)" ::: "memory");
                const u32x4 cc = *(const LAS u32x4*)(hist + 4 * lane);
                const int ls = (int)(cc.x + cc.y + cc.z + cc.w); int suf = ls;
#pragma unroll
                for (int o = 1; o < 64; o <<= 1) { const int t2 = __shfl_down(suf, o); if (lane + o < 64) suf += t2; }
                const int excl = suf - ls;
                const bool hit = (excl < remaining) && (remaining <= suf);
                int binsel = 0, above = excl;
                if (hit) { int acc = excl;
                    if (acc + (int)cc.w >= remaining) { binsel = 3; above = acc; }
                    else { acc += (int)cc.w; if (acc + (int)cc.z >= remaining) { binsel = 2; above = acc; }
                        else { acc += (int)cc.z; if (acc + (int)cc.y >= remaining) { binsel = 1; above = acc; } else { acc += (int)cc.y; binsel = 0; above = acc; } } } }
                const unsigned long long hb = __ballot(hit); const int src = __ffsll((long long)hb) - 1;
                const int bsel = __shfl(4 * lane + binsel, src), ab = __shfl(above, src);
                prefix |= ((unsigned)bsel) << shift; remaining -= ab;
                asm volatile("" ::: "memory");
            }
            const unsigned Tv = prefix;
            int neq = 0;
#pragma unroll
            for (int i = 0; i < 64; ++i) neq += (i < ni && key[i] == Tv) ? 1 : 0;
            int tot_eq = neq;
#pragma unroll
            for (int o = 32; o; o >>= 1) tot_eq += __shfl_xor(tot_eq, o);
            if (tot_eq == remaining) {
                int mine = 0;
#pragma unroll
                for (int i = 0; i < 64; ++i) mine += (i < ni && key[i] >= Tv) ? 1 : 0;
                int incl = mine;
#pragma unroll
                for (int o = 1; o < 64; o <<= 1) { const int t2 = __shfl_up(incl, o); if (lane >= o) incl += t2; }
                int my = incl - mine;
#pragma unroll
                for (int i = 0; i < 64; ++i) if (i < ni && key[i] >= Tv) { out[my] = (unsigned short)(i * 64 + lane); ++my; }
            } else {
                int pos = 0;
#pragma unroll
                for (int i = 0; i < 64; ++i) if (i < ni) { const bool pr = key[i] > Tv; const unsigned long long bal = __ballot(pr);
                    const int my = pos + (int)__builtin_amdgcn_mbcnt_hi((unsigned)(bal >> 32), __builtin_amdgcn_mbcnt_lo((unsigned)bal, 0u));
                    if (pr) out[my] = (unsigned short)(i * 64 + lane); pos += __popcll(bal); }
#pragma unroll
                for (int i = 0; i < 64; ++i) if (i < ni) { const bool pr = key[i] == Tv; const unsigned long long bal = __ballot(pr);
                    const int my = pos + (int)__builtin_amdgcn_mbcnt_hi((unsigned)(bal >> 32), __builtin_amdgcn_mbcnt_lo((unsigned)bal, 0u));
                    if (pr && my < 256) out[my] = (unsigned short)(i * 64 + lane); pos += __popcll(bal); }
            }
        }
    }
    WG_SYNC();
}

__device__ __forceinline__ void sparse_unit(LAS uchar* lds, int b, int t0, bf16_t* Q2_, const bf16_t* KV_, const unsigned short* IDX_, bool dry) {
    GAS bf16_t* Q2 = (GAS bf16_t*)Q2_; GAS const bf16_t* KV = (GAS const bf16_t*)KV_; GAS const unsigned short* IDX = (GAS const unsigned short*)IDX_;
    const int tid = opaque_tid(), lane = tid & 63, w = __builtin_amdgcn_readfirstlane(tid >> 6), c16 = lane & 15, hq = lane >> 4;
    LAS uchar* VL = lds + w * 17408;
    LAS unsigned short* IDL = (LAS unsigned short*)(lds + 139264 + w * 512);
    const int tq = t0 + w; const size_t row = (size_t)(b * T + tq);
    *(LAS u32x2*)(IDL + lane * 4) = *(GAS const u32x2*)(IDX + row * 256 + lane * 4);
    bf16x8 qf[10];
#pragma unroll
    for (int ks = 0; ks < 10; ++ks) { u32x4 z = {0u, 0u, 0u, 0u};
        if (c16 < 8) z = *(GAS const u32x4*)(Q2 + row * 3072 + (ks < 8 ? c16 * 256 + 32 * ks : 2048 + c16 * 64 + 32 * (ks - 8)) + 8 * hq);
        qf[ks] = __builtin_bit_cast(bf16x8, z); }
    float mr = NEGF, lr = 0.f; f32x4 o[16];
#pragma unroll
    for (int ct = 0; ct < 16; ++ct) o[ct] = (f32x4){0.f, 0.f, 0.f, 0.f};
    asm volatile("s_waitcnt lgkmcnt(0)" ::: "memory");
    u32x4 g[16]; bf16x8 kr0[2], kr1[2];
#define SP_ISSUE(CH) do { _Pragma("unroll") for (int it = 0; it < 16; ++it) { int id = (int)IDL[(CH) * 32 + it * 2 + (lane >> 5)]; if (id > tq) id = 0; \
            g[it] = *(GAS const u32x4*)(KV + (size_t)(b * T + id) * 320 + (lane & 31) * 8); } \
        _Pragma("unroll") for (int kt = 0; kt < 2; ++kt) { int idk = (int)IDL[(CH) * 32 + 16 * kt + c16]; if (idk > tq) idk = 0; \
            GAS const bf16_t* kr = KV + (size_t)(b * T + idk) * 320 + 256 + 8 * hq; kr0[kt] = gldvg(kr); kr1[kt] = gldvg(kr + 32); } } while (0)
    SP_ISSUE(0);
#pragma unroll 1
    for (int ch = 0; ch < 8; ++ch) {
#pragma unroll
        for (int it = 0; it < 16; ++it) *(LAS u32x4*)(VL + (it * 2 + (lane >> 5)) * 544 + (lane & 31) * 16) = g[it];
        const bf16x8 r00 = kr0[0], r01 = kr0[1], r10 = kr1[0], r11 = kr1[1];
        asm volatile("s_waitcnt lgkmcnt(0)" ::: "memory");
        if (ch < 7) SP_ISSUE(ch + 1);
        f32x4 s[2];
#pragma unroll
        for (int kt = 0; kt < 2; ++kt) {
            f32x4 acc = {0.f, 0.f, 0.f, 0.f};
#pragma unroll
            for (int ks = 0; ks < 8; ++ks) acc = mfma16(ldsv(VL + (16 * kt + c16) * 544 + (32 * ks + 8 * hq) * 2), qf[ks], acc);
            acc = mfma16(kt ? r01 : r00, qf[8], acc); acc = mfma16(kt ? r11 : r10, qf[9], acc);
            s[kt] = acc;
        }
        unsigned vm = 0u; float mx = NEGF;
#pragma unroll
        for (int kt = 0; kt < 2; ++kt) { const u32x2 idw = *(const LAS u32x2*)(IDL + ch * 32 + 16 * kt + 4 * hq);
            const int id4[4] = {(int)(idw.x & 0xffff), (int)(idw.x >> 16), (int)(idw.y & 0xffff), (int)(idw.y >> 16)};
#pragma unroll
            for (int r = 0; r < 4; ++r) if (id4[r] <= tq) { vm |= 1u << (kt * 4 + r); mx = fmaxf(mx, s[kt][r]); } }
        mx = fmaxf(mx, __shfl_xor(mx, 16)); mx = fmaxf(mx, __shfl_xor(mx, 32));
        const float mnew = fmaxf(mr, mx), alpha = __expf(mr - mnew); float sum = 0.f;
#pragma unroll
        for (int kt = 0; kt < 2; ++kt)
#pragma unroll
            for (int r = 0; r < 4; ++r) { const float p = ((vm >> (kt * 4 + r)) & 1u) ? __expf(s[kt][r] - mnew) : 0.f; s[kt][r] = p; sum += p; }
        sum += __shfl_xor(sum, 16); sum += __shfl_xor(sum, 32);
        lr = lr * alpha + sum; mr = mnew;
        const bf16x8 B = pack8(s[0], s[1]);
#pragma unroll
        for (int ct = 0; ct < 16; ++ct) {
            const s16x4 lo = tr16(VL + (4 * hq + (c16 >> 2)) * 544 + (16 * ct + 4 * (c16 & 3)) * 2), hi = tr16(VL + (16 + 4 * hq + (c16 >> 2)) * 544 + (16 * ct + 4 * (c16 & 3)) * 2);
            o[ct] = mfma16(cat4(lo, hi), B, o[ct] * alpha);
        }
        asm volatile("s_waitcnt lgkmcnt(0)" ::: "memory");
    }
#undef SP_ISSUE
    float inv = lr > 0.f ? 1.0f / lr : 0.f;
#ifdef PROBE_DSA_SCALE
    inv *= (float)(PROBE_DSA_SCALE);
#endif
    if (c16 < 8 && !dry) {
#pragma unroll
        for (int ct = 0; ct < 16; ++ct) { u32x2 wv; wv.x = pk2(o[ct][0] * inv, o[ct][1] * inv); wv.y = pk2(o[ct][2] * inv, o[ct][3] * inv);
            *(GAS u32x2*)(Q2 + row * 3072 + c16 * 256 + 16 * ct + 4 * hq) = wv; }
    }
}

__global__ void __launch_bounds__(NTHR, 2) fwd_kernel(KArgs a) {
    extern __shared__ __attribute__((aligned(16))) uchar lds_raw[];
    LAS uchar* lds = (LAS uchar*)lds_raw;
    cg::grid_group grid = cg::this_grid();
    volatile LAS unsigned* xst = (volatile LAS unsigned*)(lds + LDS_BYTES - 16);
    if (threadIdx.x < 4) xst[threadIdx.x] = 0u;
    __syncthreads();
    const XcdBarrier xb = xcd_barrier_post((unsigned*)(a.ws + WS_MISC), xst);
    for (int ph = a.ph_lo; ph < a.ph_hi; ++ph) {
        uchar* ws = a.ws; asm volatile("" : "+s"(ws));
        bf16_t* HB = (bf16_t*)(ws + WS_HB); bf16_t* R1 = (bf16_t*)(ws + WS_R1); bf16_t* R2 = (bf16_t*)(ws + WS_R2);
        float* H = a.out; asm volatile("" : "+s"(H));
        const int G = gridDim.x, bid = blockIdx.x;
        int L = 0, op = 19;
        if (ph > 0) { const int pp = ph - 1, pair = pp / 25, r = pp % 25;
            if (r < 12) { L = 2 * pair; op = r < 5 ? r : 12 + (r - 5); } else { const int r2 = r - 12; L = 2 * pair + 1; op = r2 < 6 ? 6 + r2 : 12 + (r2 - 6); } }
        const int j = L >> 1;
        const bf16_t* sl = (const bf16_t*)(ws + WS_WB) + (size_t)L * (WSLOT / 2);
        bf16_t* Z = R1; bf16_t* KC = R1 + (size_t)M * ZE; bf16_t* VC = KC + 8 * 2 * 256 * 64; bf16_t* Y = R2;
        bf16_t* Z1 = R1; bf16_t* Q2 = R1 + (size_t)M * 1024; unsigned short* IDX = (unsigned short*)R1;
        bf16_t* CQ = R2; bf16_t* KV = R2 + (size_t)M * 512; bf16_t* KI = KV + (size_t)M * 320; float* WI = (float*)(KI + (size_t)M * 64);
        bf16_t* U = R1; bf16_t* Pb = R1 + (size_t)16384 * 4096; bf16_t* PE = R2;
#ifndef PROBE_DUP
#define PROBE_DUP 0
#endif
#define MK_MLBUF float* mls = (float*)(ws + WS_MISC + 65536); const MlBuf mb{HB, mls, mls + 32 * 64 * 128, mls + 32 * 64 * 128 + 2048, mls + 32 * 64 * 128 + 4096}
        const int nrep = ((PROBE_DUP >> op) & 1) ? 2 : 1;
        for (int rep = 0; rep < nrep; ++rep) {
        switch (op) {
        case 19: prologue(a, lds); break;
        case 0: run_gemm(lds, L == 0 ? HB : R2, D, sl + OA, M, ZE, D, FStoreBf16{Z, ZE, 0}); break;
        case 1: { MK_MLBUF;
            for (int u = bid; u < 512; u += G) compress_unit(a, j, lds, u, Z, sl, KC, VC);
            for (int u = bid; u < 2048; u += G) mlstmA_unit(a, j, lds, u, Z, mb);
            break; }
        case 2: { MK_MLBUF; mlstm_scan(mb); break; }
        case 3: { MK_MLBUF;
            for (int u = bid; u < 1024; u += G) { const int i = u >> 8, wg = u & 255, bg = wg & 15, base = wg >> 4; const int qb = i == 0 ? 63 - base : (i == 1 ? 32 + base : (i == 2 ? 31 - base : base));
                nsa_unit(a, j, lds, bg >> 1, bg & 1, qb, Z, KC, VC, Y); }
            for (int u = bid; u < 2048; u += G) mlstmC_unit(a, j, lds, u, Z, Y, mb);
            break; }
        case 4: run_gemm(lds, Y, D, sl + OWOUT, M, D, D, FResid{L == 0 ? (const float*)a.in[0] : H, H, DN_ALPHA}); break;
        case 6: run_gemm(lds, R2, D, sl + OA, M, 1024, D, FStoreBf16{Z1, 1024, 0}); break;
        case 7: odd_prep(a, j, Z1, CQ, KV, KI, WI); break;
        case 8: run_gemm(lds, CQ, 512, sl + OWQ, M, 3072, 512, FQ2{Q2, (const int*)a.in[2]}); break;
        case 9:
            if (G == 256) {
                const int bb = bid & 7, li = bid >> 3;
                for (int i = 0; i < 16; ++i) { const int x = li + 32 * (i >> 1); indexer_unit<true>(lds, bb, ((i & 1) ? 511 - x : x) * 8, Q2, KI, WI, IDX); } }
            else { for (int u = bid; u < 4096; u += G) { const int uu = 4095 - u; indexer_unit<true>(lds, uu >> 9, (uu & 511) * 8, Q2, KI, WI, IDX); } }
            break;
        case 10:
            if (G == 256) { const int bb = bid & 7, li = bid >> 3;
                for (int i = 0; i < 16; ++i) sparse_unit(lds, bb, (li + 32 * i) * 8, Q2, KV, IDX, rep + 1 < nrep); }
            else { for (int u = bid; u < 4096; u += G) sparse_unit(lds, u >> 9, (u & 511) * 8, Q2, KV, IDX, rep + 1 < nrep); }
            WG_SYNC(); break;
        case 11: run_gemm(lds, Q2, 3072, sl + OWF, M, D, 2048, FResid{H, H, DN_ALPHA}); break;
        case 12: ln_pass(H, (const float*)a.in[23] + L * D, (const float*)a.in[24] + L * D, HB, (const float*)a.in[1] + (size_t)L * M * 256, Pb, (float*)(ws + WS_MISC + 4 * MiB)); break;
        case 13: run_gemm(lds, HB, D, sl + OW1, 16384, 4096, D, FStoreBf16{U, 4096, 1}); break;
        case 14: if (rep == 0) run_gemm(lds, U, 4096, sl + OW2, 16384, D, 4096, FResidLn{H, (const float*)(ws + WS_MISC + 4 * MiB), (const float*)a.in[23] + L * D, (const float*)a.in[24] + L * D});
                 run_gemm(lds, Pb, 256, sl + OWP, M, D, 256, FStoreBf16{PE, D, 0}); break;
        case 15: run_gemm(lds, HB + (size_t)16384 * D, D, sl + OW1, 16384, 4096, D, FStoreBf16{U, 4096, 1}); break;
        case 16: run_gemm(lds, U, 4096, sl + OW2, 16384, D, 4096, FResidLn{H + (size_t)16384 * D, (const float*)(ws + WS_MISC + 4 * MiB) + 2 * 16384, (const float*)a.in[23] + L * D, (const float*)a.in[24] + L * D}); break;
        case 17: ln_pass(H, (const float*)a.in[25] + L * D, (const float*)a.in[26] + L * D, HB, nullptr, nullptr, (float*)(ws + WS_MISC + 5 * MiB)); break;
        case 18: run_gemm(lds, HB, D, sl + OWG, M, D, D, FGateLn{H, PE, PE, (const float*)(ws + WS_MISC + 5 * MiB), (const float*)a.in[25] + L * D, (const float*)a.in[26] + L * D}); break;
        default: break;
        }
        if (rep + 1 < nrep) { __threadfence(); WG_SYNC(); }
        }
        if (ph + 1 < a.ph_hi) { if (ph == a.ph_lo) grid.sync(); else xcd_barrier(xb); }
#ifdef PROBE_SYNCS
        if (ph == 5) { for (int z = 0; z < PROBE_SYNCS; ++z) grid.sync(); }
#endif
    }
}
constexpr int N_PHASES = 1 + 2 * 25;

extern "C" void kernel_launch(void* const* d_in, const int* in_sizes, int n_in, void* d_out, int out_size, void* d_ws, size_t ws_size, hipStream_t stream) {
    static int grid = 0;
    if (grid == 0) {
        if (n_in != 31 || out_size != M * D || ws_size < WS_NEED) { fprintf(stderr, "kernel_launch: unexpected problem (n_in %d out %d ws %zu)\n", n_in, out_size, ws_size); grid = -1; return; }
        int dev = 0, cus = 0, per_cu = 0;
        hipGetDevice(&dev); hipDeviceGetAttribute(&cus, hipDeviceAttributeMultiprocessorCount, dev);
        if (hipFuncSetAttribute((const void*)fwd_kernel, hipFuncAttributeMaxDynamicSharedMemorySize, LDS_BYTES) != hipSuccess) { fprintf(stderr, "kernel_launch: hipFuncSetAttribute failed\n"); grid = -1; return; }
        if (hipOccupancyMaxActiveBlocksPerMultiprocessor(&per_cu, (const void*)fwd_kernel, NTHR, LDS_BYTES) != hipSuccess || per_cu < 1) { fprintf(stderr, "kernel_launch: occupancy query gave %d\n", per_cu); per_cu = 1; }
        (void)hipGetLastError();
        grid = cus * 1;
        fprintf(stderr, "kernel_launch: grid %d (cus %d, per_cu %d)\n", grid, cus, per_cu);
    }
    if (grid < 0) return;
    if (hipMemsetAsync((char*)d_ws + WS_MISC, 0, 16384, stream) != hipSuccess) { fprintf(stderr, "kernel_launch: memset failed\n"); return; }
    KArgs a{};
    for (int i = 0; i < 31; ++i) a.in[i] = d_in[i];
    a.out = (float*)d_out; a.ws = (uchar*)d_ws;
#ifndef MK_MULTI
    a.ph_lo = 0; a.ph_hi = N_PHASES;
    void* args[] = {&a};
    hipError_t e = hipLaunchCooperativeKernel((const void*)fwd_kernel, dim3(grid), dim3(NTHR), args, LDS_BYTES, stream);
    if (e != hipSuccess) fprintf(stderr, "cooperative launch failed: %s (grid %d)\n", hipGetErrorString(e), grid);
#else
    for (int p = 0; p < N_PHASES; ++p) { a.ph_lo = p; a.ph_hi = p + 1; hipLaunchKernelGGL(fwd_kernel, dim3(grid), dim3(NTHR), LDS_BYTES, stream, a); }
#endif
}
```

```cpp
#include <hip/hip_runtime.h>
#include <hip/hip_cooperative_groups.h>
#include <cstdio>
#include <cstdint>
namespace cg = cooperative_groups;

#define LAS __attribute__((address_space(3)))
typedef unsigned char uchar;
typedef unsigned short bf16_t;
typedef short bf16x8 __attribute__((ext_vector_type(8)));
typedef short s16x4 __attribute__((ext_vector_type(4)));
typedef float f32x4 __attribute__((ext_vector_type(4)));
typedef unsigned u32x4 __attribute__((ext_vector_type(4)));
typedef unsigned u32x2 __attribute__((ext_vector_type(2)));

__device__ __forceinline__ int opaque_tid() { int t = threadIdx.x; asm volatile("" : "+v"(t)); return t; }

namespace pg8 {
#define PG8_LAS __attribute__((address_space(3)))
constexpr int BM = 256, BK = 64, HALF = 128, HTB = HALF * BK * 2, STAGE_BYTES = 8 * HTB, NXCD = 8, WGM = 8;
__host__ __device__ __forceinline__ int lds_byte(int r, int c) { const int st = (r >> 4) * 2 + (c >> 5), rr = r & 15, cc = c & 31, ob = rr * 64 + cc * 2; return st * 1024 + (ob ^ (((ob >> 9) & 1) << 5)); }
__host__ __device__ __forceinline__ void stage_rc(int b, int& R, int& C) { const int st = b / 1024, sb = b % 1024, swz = sb ^ (((sb >> 9) & 1) << 5); R = (st >> 1) * 16 + swz / 64; C = (st & 1) * 32 + (swz % 64) / 2; }
__host__ __device__ __forceinline__ int perm32(int rho) { const int n = rho >> 4, i = rho & 15; return 8 * (i >> 2) + 4 * n + (i & 3); }
struct Unit { int pm, pn; };
struct Gemm { const bf16_t* A; const bf16_t* Bt; int M, N, K, lda; };
struct StaticOrder {
    int nM, nN, nwg, G, c;
    __host__ __device__ void init(int M, int N, int G_, int c_) { nM = M / BM; nN = N / BM; nwg = nM * nN; G = G_; c = c_; }
    __host__ __device__ bool next(int i, Unit& u) const {
        const long L = (long)i * G + c; if (L >= nwg) return false;
        int wgid = (int)L; { const int q = nwg / NXCD, r = nwg % NXCD, xcd = wgid % NXCD, off = wgid / NXCD; wgid = (xcd < r ? xcd * (q + 1) : r * (q + 1) + (xcd - r) * q) + off; }
        const int nig = WGM * nN, gid = wgid / nig, fm = gid * WGM, gsz = (nM - fm) < WGM ? (nM - fm) : WGM;
        u.pm = fm + ((wgid % nig) % gsz); u.pn = (wgid % nig) / gsz; return true;
    }
    __device__ __forceinline__ void a_ready(const Unit&) const {}
    __device__ __forceinline__ void done(const Unit&) const {}
};
__device__ __forceinline__ unsigned cvt_pk_bf16(float lo, float hi) { unsigned r; asm volatile("v_cvt_pk_bf16_f32 %0, %1, %2" : "=v"(r) : "v"(lo), "v"(hi)); return r; }
template <class F> struct Epi8 {
    static constexpr bool PERM = true, AFTER_DRAIN = false; F f;
    __device__ __forceinline__ void operator()(const f32x4 (&acc)[2][2][4][2], const Unit& u, int wr, int wc, int fr, int fq) const {
#pragma unroll
        for (int ai = 0; ai < 2; ++ai)
#pragma unroll
            for (int m = 0; m < 4; ++m)
#pragma unroll
                for (int bj = 0; bj < 2; ++bj) {
                    const int row = u.pm * BM + ai * HALF + wr * 64 + m * 16 + fr, col = u.pn * BM + bj * HALF + wc * 32 + 8 * fq;
                    f(row, col, acc[ai][bj][m][0], acc[ai][bj][m][1]);
                }
    }
};
template <class Epi, class Sched, bool ALIGN_EPI = false, bool SP2 = false>
__device__ __forceinline__ void gemm_phase(PG8_LAS unsigned char* lds, const Gemm g, const Sched& S, const Epi& E) {
    const int tid = opaque_tid(), wid = __builtin_amdgcn_readfirstlane(tid >> 6), lane = tid & 63, wr = wid >> 2, wc = wid & 3, fr = lane & 15, fq = lane >> 4;
    const int K = g.K, nt = K / BK;
    unsigned voffA[2], voffB[2];
#pragma unroll
    for (int i = 0; i < 2; ++i) { int R, C; stage_rc(tid * 16 + i * 8192, R, C); const int Rb = Epi::PERM ? ((R & ~31) + perm32(R & 31)) : R;
        voffA[i] = (unsigned)(R * g.lda + C) * 2u; voffB[i] = (unsigned)(Rb * K + C) * 2u; }
    const size_t kstep = (size_t)(BK * 2);
    const size_t hstepA = (size_t)HALF * g.lda * 2, hstepB = (size_t)HALF * K * 2;
    const size_t tstepA = 2 * hstepA, tstepB = 2 * hstepB;
    const unsigned ldsw = (unsigned)wid * 1024u;
    const int aoff = lds_byte(wr * 64 + fr, fq * 8), boff = lds_byte(wc * 32 + fr, fq * 8);
#define PG8_SA(b, h) (((b) * 2 + (h)) * HTB)
#define PG8_SB(b, h) ((4 + (b) * 2 + (h)) * HTB)
#define PG8_STAGE(bufoff, gbase, voff) do { _Pragma("unroll") for (int _i = 0; _i < 2; ++_i) \
        __builtin_amdgcn_global_load_lds((const unsigned*)((const char*)(gbase) + (voff)[_i]), (PG8_LAS unsigned*)(lds + (bufoff) + ldsw + _i * 8192), 16, 0, 0); } while (0)
#define PG8_LDA(dst, b, h) do { _Pragma("unroll") for (int m = 0; m < 4; ++m) _Pragma("unroll") for (int k = 0; k < 2; ++k) dst[m][k] = *(const PG8_LAS bf16x8*)(lds + PG8_SA(b, h) + aoff + m * 2048 + k * 1024); } while (0)
#define PG8_LDB(dst, b, h) do { _Pragma("unroll") for (int n = 0; n < 2; ++n) _Pragma("unroll") for (int k = 0; k < 2; ++k) dst[n][k] = *(const PG8_LAS bf16x8*)(lds + PG8_SB(b, h) + boff + n * 2048 + k * 1024); } while (0)
#define PG8_MMA(ai, bj, At, Bt) do { __builtin_amdgcn_s_setprio(1); _Pragma("unroll") for (int m = 0; m < 4; ++m) _Pragma("unroll") for (int n = 0; n < 2; ++n) _Pragma("unroll") for (int k = 0; k < 2; ++k) \
        acc[ai][bj][m][n] = __builtin_amdgcn_mfma_f32_16x16x32_bf16(Bt[n][k], At[m][k], acc[ai][bj][m][n], 0, 0, 0); __builtin_amdgcn_s_setprio(0); } while (0)
#define PG8_WAIT_V(n) asm volatile("s_waitcnt vmcnt(" #n ")" ::: "memory")
#define PG8_WAIT_L(n) asm volatile("s_waitcnt lgkmcnt(" #n ")" ::: "memory")
#define PG8_BAR __builtin_amdgcn_s_barrier()
#define PG8_SCHED __builtin_amdgcn_sched_barrier(0)
    Unit cur, nxt; int ui = 0;
    if (!S.next(0, cur)) return;
    f32x4 acc[2][2][4][2];
#pragma unroll
    for (int a = 0; a < 2; ++a)
#pragma unroll
        for (int b = 0; b < 2; ++b)
#pragma unroll
            for (int m = 0; m < 4; ++m)
#pragma unroll
                for (int n = 0; n < 2; ++n) acc[a][b][m][n] = (f32x4){0.f, 0.f, 0.f, 0.f};
    bf16x8 At[4][2], B0[2][2], B1[2][2];
    const char* cA = (const char*)g.A + (size_t)cur.pm * tstepA; const char* cB = (const char*)g.Bt + (size_t)cur.pn * tstepB;
    S.a_ready(cur);
    if constexpr (SP2) {
        PG8_STAGE(PG8_SB(0, 0), cB, voffB); PG8_STAGE(PG8_SB(0, 1), cB + hstepB, voffB); PG8_STAGE(PG8_SA(0, 0), cA, voffA); PG8_STAGE(PG8_SA(0, 1), cA + hstepA, voffA);
        if (wr == 1) PG8_BAR;
        PG8_WAIT_V(2); PG8_BAR;
        PG8_STAGE(PG8_SB(1, 0), cB + kstep, voffB); PG8_STAGE(PG8_SA(1, 0), cA + kstep, voffA); PG8_STAGE(PG8_SB(1, 1), cB + hstepB + kstep, voffB);
        PG8_WAIT_V(6); PG8_BAR;
    } else {
        PG8_STAGE(PG8_SB(0, 0), cB, voffB); PG8_STAGE(PG8_SA(0, 0), cA, voffA); PG8_STAGE(PG8_SB(0, 1), cB + hstepB, voffB); PG8_STAGE(PG8_SA(0, 1), cA + hstepA, voffA);
        if (wr == 1) PG8_BAR;
        PG8_WAIT_V(4); PG8_BAR;
        PG8_STAGE(PG8_SB(1, 0), cB + kstep, voffB); PG8_STAGE(PG8_SA(1, 0), cA + kstep, voffA); PG8_STAGE(PG8_SB(1, 1), cB + hstepB + kstep, voffB);
        PG8_WAIT_V(6); PG8_BAR;
    }
    for (;;) {
        const bool has_next = S.next(ui + 1, nxt);
        const char* nA = has_next ? (const char*)g.A + (size_t)nxt.pm * tstepA : cA; const char* nB = has_next ? (const char*)g.Bt + (size_t)nxt.pn * tstepB : cB;
        for (int t = 0; t < nt; t += 2) {
            const bool last = (t == nt - 2);
            const char* a1 = cA + (size_t)(t + 1) * kstep;
            const char* a2 = last ? nA : cA + (size_t)(t + 2) * kstep; const char* b2 = last ? nB : cB + (size_t)(t + 2) * kstep;
            const char* a3 = a2 + kstep; const char* b3 = b2 + kstep;
            if (last && has_next) S.a_ready(nxt);
            if constexpr (SP2) {
            PG8_LDB(B0, 0, 0); PG8_LDB(B1, 0, 1); PG8_SCHED; PG8_LDA(At, 0, 0); PG8_STAGE(PG8_SA(1, 1), a1 + hstepA, voffA);
            PG8_WAIT_V(8); PG8_WAIT_L(0); PG8_BAR; PG8_MMA(0, 0, At, B0); PG8_MMA(0, 1, At, B1); PG8_BAR; PG8_SCHED;
            PG8_LDA(At, 0, 1); PG8_STAGE(PG8_SB(0, 0), b2, voffB); PG8_STAGE(PG8_SB(0, 1), b2 + hstepB, voffB); PG8_STAGE(PG8_SA(0, 0), a2, voffA);
            PG8_WAIT_V(8); PG8_WAIT_L(0); PG8_BAR; PG8_MMA(1, 0, At, B0); PG8_MMA(1, 1, At, B1); PG8_BAR; PG8_SCHED;
            PG8_LDB(B0, 1, 0); PG8_LDB(B1, 1, 1); PG8_SCHED; PG8_LDA(At, 1, 0); PG8_STAGE(PG8_SA(0, 1), a2 + hstepA, voffA);
            PG8_WAIT_V(8); PG8_WAIT_L(0); PG8_BAR; PG8_MMA(0, 0, At, B0); PG8_MMA(0, 1, At, B1); PG8_BAR; PG8_SCHED;
            PG8_LDA(At, 1, 1); PG8_STAGE(PG8_SB(1, 0), b3, voffB); PG8_STAGE(PG8_SB(1, 1), b3 + hstepB, voffB); PG8_STAGE(PG8_SA(1, 0), a3, voffA);
            PG8_WAIT_V(8); PG8_WAIT_L(0); PG8_BAR; PG8_MMA(1, 0, At, B0); PG8_MMA(1, 1, At, B1); PG8_BAR; PG8_SCHED;
            } else {
            PG8_LDB(B0, 0, 0); PG8_SCHED; PG8_LDA(At, 0, 0); PG8_STAGE(PG8_SA(1, 1), a1 + hstepA, voffA);
            PG8_WAIT_L(8); PG8_BAR; PG8_WAIT_L(0); PG8_MMA(0, 0, At, B0); PG8_BAR; PG8_SCHED;
            PG8_LDB(B1, 0, 1); PG8_STAGE(PG8_SB(0, 0), b2, voffB);
            PG8_BAR; PG8_WAIT_L(0); PG8_MMA(0, 1, At, B1); PG8_BAR;
            PG8_LDA(At, 0, 1); PG8_STAGE(PG8_SA(0, 0), a2, voffA);
            PG8_BAR; PG8_WAIT_L(0); PG8_MMA(1, 0, At, B0); PG8_BAR; PG8_SCHED;
            PG8_STAGE(PG8_SB(0, 1), b2 + hstepB, voffB);
            PG8_WAIT_V(6); PG8_BAR; PG8_MMA(1, 1, At, B1); PG8_BAR;
            PG8_LDB(B0, 1, 0); PG8_SCHED; PG8_LDA(At, 1, 0); PG8_STAGE(PG8_SA(0, 1), a2 + hstepA, voffA);
            PG8_WAIT_L(8); PG8_BAR; PG8_WAIT_L(0); PG8_MMA(0, 0, At, B0); PG8_BAR; PG8_SCHED;
            PG8_LDB(B1, 1, 1); PG8_STAGE(PG8_SB(1, 0), b3, voffB);
            PG8_BAR; PG8_WAIT_L(0); PG8_MMA(0, 1, At, B1); PG8_BAR;
            PG8_LDA(At, 1, 1); PG8_STAGE(PG8_SA(1, 0), a3, voffA);
            PG8_BAR; PG8_WAIT_L(0); PG8_MMA(1, 0, At, B0); PG8_BAR; PG8_SCHED;
            PG8_STAGE(PG8_SB(1, 1), b3 + hstepB, voffB);
            PG8_WAIT_V(6); PG8_BAR; PG8_MMA(1, 1, At, B1); PG8_BAR;
            }
        }
        if constexpr (ALIGN_EPI) { if (wr == 0) PG8_BAR; }
        if constexpr (!Epi::AFTER_DRAIN) { E(acc, cur, wr, wc, fr, fq); S.done(cur); }
        if (!has_next) break;
#pragma unroll
        for (int a = 0; a < 2; ++a)
#pragma unroll
            for (int b = 0; b < 2; ++b)
#pragma unroll
                for (int m = 0; m < 4; ++m)
#pragma unroll
                    for (int n = 0; n < 2; ++n) acc[a][b][m][n] = (f32x4){0.f, 0.f, 0.f, 0.f};
        cur = nxt; cA = nA; cB = nB; ++ui;
        if constexpr (ALIGN_EPI) { if (wr == 1) PG8_BAR; }
    }
    PG8_WAIT_V(0);
    if constexpr (!ALIGN_EPI) { if (wr == 0) PG8_BAR; }
    PG8_BAR;
    if constexpr (Epi::AFTER_DRAIN) { E.fused(acc, cur, wr, wc, fr, fq, lds, wid, lane); S.done(cur); }
#undef PG8_SA
#undef PG8_SB
#undef PG8_STAGE
#undef PG8_LDA
#undef PG8_LDB
#undef PG8_MMA
#undef PG8_WAIT_V
#undef PG8_WAIT_L
#undef PG8_BAR
#undef PG8_SCHED
}}
using pg8::Gemm; using pg8::StaticOrder; using pg8::Epi8;

constexpr int NB = 8, T = 4096, M = NB * T, D = 1024;
constexpr float DN_ALPHA = 1.6817928305074292f;
constexpr float LN_EPS = 1e-5f, NEGF = -1e30f;
constexpr int ZE = 3584;
constexpr int C_AQ = 0, C_AK = 512, C_AV = 1024, C_AO = 1536, C_AI = 2048, C_AF = 2052, C_BQ = 2056, C_BKC = 2568, C_BVC = 2696, C_BKS = 2824, C_BVS = 2952, C_BKW = 3080, C_BVW = 3208, C_BG = 3336;
constexpr size_t MiB = 1u << 20;
constexpr size_t WS_WB = 0, WSLOT = 29 * MiB, WS_HB = 116 * MiB, WS_R1 = 180 * MiB, WS_R2 = 436 * MiB, WS_MISC = 500 * MiB, WS_NEED = 512 * MiB;
constexpr size_t OW1 = 0, OW2 = 4194304, OWG = 8388608, OWP = 9437184, OA = 9699328, OWOUT = OA + 3670016, OCW1 = OWOUT + 1048576, OCW2 = OCW1 + 524288, OWQ = OA + 1048576, OWF = OWQ + 1572864;
static_assert((OCW2 + 16384) * 2 <= WSLOT && (OWF + 2097152) * 2 <= WSLOT, "weight slot");
constexpr int LDS_BYTES = 147456;
constexpr int NTHR = 512;

struct KArgs { const void* in[31]; float* out; uchar* ws; int ph_lo, ph_hi; };
#define GAS __attribute__((address_space(1)))

__device__ __forceinline__ unsigned f2bf(float f) { unsigned u = __float_as_uint(f); return (u + 0x7fffu + ((u >> 16) & 1u)) >> 16; }
__device__ __forceinline__ float bflo(unsigned w) { return __uint_as_float(w << 16); }
__device__ __forceinline__ float bfhi(unsigned w) { return __uint_as_float(w & 0xffff0000u); }
__device__ __forceinline__ float bf2f(bf16_t b) { return __uint_as_float(((unsigned)b) << 16); }
typedef float f32x2_t __attribute__((ext_vector_type(2)));
typedef __bf16 bf16x2_t __attribute__((ext_vector_type(2)));
__device__ __forceinline__ unsigned pk2(float lo, float hi) { f32x2_t v = {lo, hi}; bf16x2_t b = __builtin_convertvector(v, bf16x2_t); return __builtin_bit_cast(unsigned, b); }
__device__ __forceinline__ float wave_sum(float v) {
#pragma unroll
    for (int o = 32; o; o >>= 1) v += __shfl_xor(v, o);
    return v; }
__device__ __forceinline__ f32x4 mfma16(bf16x8 a, bf16x8 b, f32x4 c) { return __builtin_amdgcn_mfma_f32_16x16x32_bf16(a, b, c, 0, 0, 0); }
__device__ __forceinline__ bf16x8 ldsv(LAS const uchar* p) { return *(const LAS bf16x8*)p; }
__device__ __forceinline__ s16x4 tr16(LAS const uchar* p) { return __builtin_bit_cast(s16x4, __builtin_amdgcn_ds_read_tr16_b64_v4i16((LAS s16x4*)p)); }
__device__ __forceinline__ bf16x8 cat4(s16x4 a, s16x4 b) { bf16x8 r; r[0] = a[0]; r[1] = a[1]; r[2] = a[2]; r[3] = a[3]; r[4] = b[0]; r[5] = b[1]; r[6] = b[2]; r[7] = b[3]; return r; }
__device__ __forceinline__ bf16x8 gldv(const bf16_t* p) { return __builtin_bit_cast(bf16x8, *(const u32x4*)p); }
__device__ __forceinline__ bf16x8 gldvg(GAS const bf16_t* p) { return __builtin_bit_cast(bf16x8, *(GAS const u32x4*)p); }
__device__ __forceinline__ bf16x8 pack8(f32x4 a, f32x4 b) { u32x4 w; w.x = pk2(a[0], a[1]); w.y = pk2(a[2], a[3]); w.z = pk2(b[0], b[1]); w.w = pk2(b[2], b[3]); return __builtin_bit_cast(bf16x8, w); }
__device__ __forceinline__ float sigmoidf_(float x) { return 1.0f / (1.0f + __expf(-x)); }
__device__ __forceinline__ void sincos_rev(float ang, float& s, float& c) { float r = ang * 0.15915494309189535f; r -= floorf(r); s = __builtin_amdgcn_sinf(r); c = __builtin_amdgcn_cosf(r); }
#define WG_SYNC() __syncthreads()

struct FStoreBf16 { bf16_t* O; int ldc; int relu2;
    __device__ __forceinline__ void operator()(int row, int col, f32x4 a, f32x4 b) const {
        if (relu2) {
#pragma unroll
            for (int i = 0; i < 4; ++i) { float x = fmaxf(a[i], 0.f); a[i] = x * x; float y = fmaxf(b[i], 0.f); b[i] = y * y; } }
        u32x4 w; w.x = pk2(a[0], a[1]); w.y = pk2(a[2], a[3]); w.z = pk2(b[0], b[1]); w.w = pk2(b[2], b[3]);
        *(GAS u32x4*)((GAS bf16_t*)O + (size_t)row * ldc + col) = w; } };
struct FResid { const float* Hs; float* H; float alpha;
    __device__ __forceinline__ void operator()(int row, int col, f32x4 a, f32x4 b) const {
        const size_t o = (size_t)row * D + col; const f32x4 h0 = *(GAS const f32x4*)((GAS const float*)Hs + o), h1 = *(GAS const f32x4*)((GAS const float*)Hs + o + 4);
        *(GAS f32x4*)((GAS float*)H + o) = h0 * alpha + a; *(GAS f32x4*)((GAS float*)H + o + 4) = h1 * alpha + b; } };
struct FResidLn { float* H; const float* ST; const float* g; const float* b;
    __device__ __forceinline__ void operator()(int row, int col, f32x4 a, f32x4 c) const {
        GAS float* p = (GAS float*)H + (size_t)row * D + col; const f32x4 x0 = *(GAS f32x4*)p, x1 = *(GAS f32x4*)(p + 4);
        const float mu = ((GAS const float*)ST)[2 * row], rs = ((GAS const float*)ST)[2 * row + 1];
        GAS const float* gg = (GAS const float*)g + col; GAS const float* bb = (GAS const float*)b + col;
        const f32x4 g0 = *(GAS const f32x4*)gg, g1 = *(GAS const f32x4*)(gg + 4), b0 = *(GAS const f32x4*)bb, b1 = *(GAS const f32x4*)(bb + 4);
        *(GAS f32x4*)p = ((x0 - mu) * rs * g0 + b0) * DN_ALPHA + a; *(GAS f32x4*)(p + 4) = ((x1 - mu) * rs * g1 + b1) * DN_ALPHA + c; } };
struct FGateLn { float* H; bf16_t* HB; const bf16_t* PE; const float* ST; const float* g; const float* b;
    __device__ __forceinline__ void operator()(int row, int col, f32x4 a, f32x4 c) const {
        const size_t o = (size_t)row * D + col; GAS float* p = (GAS float*)H + o; const f32x4 x0 = *(GAS f32x4*)p, x1 = *(GAS f32x4*)(p + 4); const u32x4 pe = *(GAS const u32x4*)((GAS const bf16_t*)PE + o);
        const float mu = ((GAS const float*)ST)[2 * row], rs = ((GAS const float*)ST)[2 * row + 1];
        GAS const float* gg = (GAS const float*)g + col; GAS const float* bb = (GAS const float*)b + col;
        const f32x4 g0 = *(GAS const f32x4*)gg, g1 = *(GAS const f32x4*)(gg + 4), b0 = *(GAS const f32x4*)bb, b1 = *(GAS const f32x4*)(bb + 4);
        f32x4 h0 = (x0 - mu) * rs * g0 + b0, h1 = (x1 - mu) * rs * g1 + b1;
        h0[0] += sigmoidf_(a[0]) * bflo(pe.x); h0[1] += sigmoidf_(a[1]) * bfhi(pe.x); h0[2] += sigmoidf_(a[2]) * bflo(pe.y); h0[3] += sigmoidf_(a[3]) * bfhi(pe.y);
        h1[0] += sigmoidf_(c[0]) * bflo(pe.z); h1[1] += sigmoidf_(c[1]) * bfhi(pe.z); h1[2] += sigmoidf_(c[2]) * bflo(pe.w); h1[3] += sigmoidf_(c[3]) * bfhi(pe.w);
        *(GAS f32x4*)p = h0; *(GAS f32x4*)(p + 4) = h1;
        u32x4 w; w.x = pk2(h0[0], h0[1]); w.y = pk2(h0[2], h0[3]); w.z = pk2(h1[0], h1[1]); w.w = pk2(h1[2], h1[3]); *(GAS u32x4*)((GAS bf16_t*)HB + o) = w; } };
struct FGate { float* H; bf16_t* HB; const bf16_t* PE;
    __device__ __forceinline__ void operator()(int row, int col, f32x4 a, f32x4 b) const {
        const size_t o = (size_t)row * D + col; float* p = H + o; f32x4 h0 = *(f32x4*)p, h1 = *(f32x4*)(p + 4); const u32x4 pe = *(const u32x4*)(PE + o);
        h0[0] += sigmoidf_(a[0]) * bflo(pe.x); h0[1] += sigmoidf_(a[1]) * bfhi(pe.x); h0[2] += sigmoidf_(a[2]) * bflo(pe.y); h0[3] += sigmoidf_(a[3]) * bfhi(pe.y);
        h1[0] += sigmoidf_(b[0]) * bflo(pe.z); h1[1] += sigmoidf_(b[1]) * bfhi(pe.z); h1[2] += sigmoidf_(b[2]) * bflo(pe.w); h1[3] += sigmoidf_(b[3]) * bfhi(pe.w);
        *(f32x4*)p = h0; *(f32x4*)(p + 4) = h1;
        u32x4 w; w.x = pk2(h0[0], h0[1]); w.y = pk2(h0[2], h0[3]); w.z = pk2(h1[0], h1[1]); w.w = pk2(h1[2], h1[3]); *(u32x4*)(HB + o) = w; } };
struct FQ2 { bf16_t* Q2; const int* pos;
    __device__ __forceinline__ void operator()(int row, int col, f32x4 a, f32x4 b) const {
        GAS bf16_t* rp = (GAS bf16_t*)Q2 + (size_t)row * 3072;
        if (col < 2048) { u32x4 w; w.x = pk2(a[0], a[1]); w.y = pk2(a[2], a[3]); w.z = pk2(b[0], b[1]); w.w = pk2(b[2], b[3]); *(GAS u32x4*)(rp + col) = w; return; }
        const float ps = (float)((GAS const int*)pos)[row];
        int e, half, i0; float lg;
        if (col < 2560) { e = col - 2048; half = 32; lg = 13.287712379549449f * (2.0f / 64.0f); }
        else { e = col - 2560; half = 16; lg = 13.287712379549449f * (2.0f / 32.0f);
            if ((e & 63) >= 32) { u32x4 w; w.x = pk2(a[0], a[1]); w.y = pk2(a[2], a[3]); w.z = pk2(b[0], b[1]); w.w = pk2(b[2], b[3]); *(GAS u32x4*)(rp + col) = w; return; } }
        const int hb = (col - (e & 63)); i0 = (e & 63) >> 1;
        float x1[4] = {a[0], a[2], b[0], b[2]}, x2[4] = {a[1], a[3], b[1], b[3]}, o1[4], o2[4];
#pragma unroll
        for (int i = 0; i < 4; ++i) { const float inv = exp2f(-(float)(i0 + i) * lg); float s, c; sincos_rev(ps * inv, s, c); o1[i] = x1[i] * c - x2[i] * s; o2[i] = x1[i] * s + x2[i] * c; }
        u32x2 w1, w2; w1.x = pk2(o1[0], o1[1]); w1.y = pk2(o1[2], o1[3]); w2.x = pk2(o2[0], o2[1]); w2.y = pk2(o2[2], o2[3]);
        *(GAS u32x2*)(rp + hb + i0) = w1; *(GAS u32x2*)(rp + hb + half + i0) = w2; } };

template <class F> __device__ __forceinline__ void run_gemm(LAS uchar* lds, const bf16_t* A, int lda, const bf16_t* Bt, int Mr, int N, int K, const F& f) {
    Gemm g{A, Bt, Mr, N, K, lda}; StaticOrder S; S.init(Mr, N, (int)gridDim.x, (int)blockIdx.x); Epi8<F> E{f};
    pg8::gemm_phase<Epi8<F>, StaticOrder, true, true>(lds, g, S, E);
    WG_SYNC();
}

__device__ __forceinline__ void conv_T(const float* W, int K, int N, int Npad, bf16_t* WT, LAS float* tile0) {
    const int tid = opaque_tid(), lane = tid & 63, w = tid >> 6, nk = K / 64, nn = Npad / 64;
    LAS float* tile = tile0 + w * (64 * 65 + 16);
    int gw = blockIdx.x * 8 + w; asm volatile("" : "+v"(gw));
    const int nw = gridDim.x * 8;
    for (int item = gw; item < nk * nn; item += nw) {
        const int kt = item / nn, nt = item % nn;
        if ((N & 3) == 0) {
            f32x4 v[16];
#pragma unroll
            for (int i = 0; i < 16; ++i) { const int r = (lane >> 4) + 4 * i, c = (lane & 15) * 4, n = nt * 64 + c; v[i] = (f32x4){0.f, 0.f, 0.f, 0.f}; if (n < N) v[i] = *(const f32x4*)(W + (size_t)(kt * 64 + r) * N + n); }
#pragma unroll
            for (int i = 0; i < 16; ++i) { const int r = (lane >> 4) + 4 * i, c = (lane & 15) * 4; tile[r * 65 + c] = v[i][0]; tile[r * 65 + c + 1] = v[i][1]; tile[r * 65 + c + 2] = v[i][2]; tile[r * 65 + c + 3] = v[i][3]; }
        } else {
#pragma unroll 8
            for (int r = 0; r < 64; ++r) { const int n = nt * 64 + lane; tile[r * 65 + lane] = n < N ? W[(size_t)(kt * 64 + r) * N + n] : 0.f; }
        }
        asm volatile("s_waitcnt lgkmcnt(0)" ::: "memory");
#pragma unroll
        for (int i = 0; i < 8; ++i) { const int n = (lane >> 3) + 8 * i, kg = (lane & 7) * 8; u32x4 o;
            o.x = pk2(tile[(kg + 0) * 65 + n], tile[(kg + 1) * 65 + n]); o.y = pk2(tile[(kg + 2) * 65 + n], tile[(kg + 3) * 65 + n]);
            o.z = pk2(tile[(kg + 4) * 65 + n], tile[(kg + 5) * 65 + n]); o.w = pk2(tile[(kg + 6) * 65 + n], tile[(kg + 7) * 65 + n]);
            *(u32x4*)(WT + (size_t)(nt * 64 + n) * K + kt * 64 + kg) = o; }
        asm volatile("s_waitcnt lgkmcnt(0)" ::: "memory");
    }
}

__device__ __forceinline__ void prologue(const KArgs& a, LAS uchar* lds) {
    LAS float* tile = (LAS float*)lds;
    bf16_t* WB = (bf16_t*)(a.ws + WS_WB);
    const int tid = opaque_tid(), lane = tid & 63, gw = blockIdx.x * 8 + (tid >> 6), nw = gridDim.x * 8;
    for (int L = 0; L < 4; ++L) {
        const int j = L >> 1; bf16_t* sl = WB + (size_t)L * (WSLOT / 2);
        conv_T((const float*)a.in[27] + (size_t)L * 1024 * 4096, 1024, 4096, 4096, sl + OW1, tile);
        conv_T((const float*)a.in[28] + (size_t)L * 4096 * 1024, 4096, 1024, 1024, sl + OW2, tile);
        conv_T((const float*)a.in[29] + (size_t)L * 1024 * 1024, 1024, 1024, 1024, sl + OWG, tile);
        conv_T((const float*)a.in[30] + (size_t)L * 256 * 1024, 256, 1024, 1024, sl + OWP, tile);
        if ((L & 1) == 0) {
            conv_T((const float*)a.in[3] + (size_t)j * 1024 * 3360, 1024, 3360, 3584, sl + OA, tile);
            conv_T((const float*)a.in[12] + (size_t)j * 1024 * 1024, 1024, 1024, 1024, sl + OWOUT, tile);
            for (int jk = 0; jk < 2; ++jk) {
                conv_T((const float*)a.in[9] + (size_t)(j * 2 + jk) * 2048 * 128, 2048, 128, 128, sl + OCW1 + (size_t)jk * 128 * 2048, tile);
                conv_T((const float*)a.in[10] + (size_t)(j * 2 + jk) * 128 * 64, 128, 64, 64, sl + OCW2 + (size_t)jk * 64 * 128, tile);
            }
        } else {
            conv_T((const float*)a.in[13] + (size_t)j * 1024 * 904, 1024, 904, 1024, sl + OA, tile);
            const float* wqb = (const float*)a.in[16] + (size_t)j * 512 * 1536;
            const float* wuk = (const float*)a.in[17] + (size_t)j * 256 * 1024;
            const float* wuv = (const float*)a.in[18] + (size_t)j * 256 * 1024;
            const float* wiq = (const float*)a.in[19] + (size_t)j * 512 * 512;
            const float* wout = (const float*)a.in[22] + (size_t)j * 1024 * 1024;
            bf16_t* WQ = sl + OWQ; bf16_t* WF = sl + OWF;
            const float qs = 0.07216878364870322f;
            for (int tl = gw; tl < 8 * 16 * 32; tl += nw) {
                const int h = tl >> 9, ct = (tl >> 5) & 15, kt = tl & 31, c16 = lane & 15, hq = lane >> 4;
                f32x4 acc = {0.f, 0.f, 0.f, 0.f};
#pragma unroll
                for (int ks = 0; ks < 4; ++ks) {
                    const float* ap = wqb + (size_t)(kt * 16 + c16) * 1536 + h * 192 + 32 * ks + 8 * hq; const float* bp = wuk + (size_t)(ct * 16 + c16) * 1024 + h * 128 + 32 * ks + 8 * hq;
                    acc = mfma16(pack8(*(const f32x4*)ap, *(const f32x4*)(ap + 4)), pack8(*(const f32x4*)bp, *(const f32x4*)(bp + 4)), acc); }
                u32x2 o; o.x = pk2(acc[0] * qs, acc[1] * qs); o.y = pk2(acc[2] * qs, acc[3] * qs);
                *(u32x2*)(WQ + (size_t)(h * 256 + ct * 16 + c16) * 512 + kt * 16 + 4 * hq) = o;
            }
            for (int n = 2048 + gw; n < 3072; n += nw) {
                int col; float sc; const float* src; int ld;
                if (n < 2560) { const int e = n - 2048, h = e >> 6, ee = e & 63; col = h * 192 + 128 + (ee >> 1) + 32 * (ee & 1); sc = qs; src = wqb; ld = 1536; }
                else { const int e = n - 2560, h = e >> 6, ee = e & 63; const int dc = ee < 32 ? ((ee >> 1) + 16 * (ee & 1)) : ee; col = h * 64 + dc; sc = 1.f; src = wiq; ld = 512; }
#pragma unroll
                for (int i2 = 0; i2 < 8; ++i2) { const int k = lane + 64 * i2; WQ[(size_t)n * 512 + k] = (bf16_t)f2bf(src[(size_t)k * ld + col] * sc); }
            }
            for (int tl = gw; tl < 8 * 16 * 64; tl += nw) {
                const int h = tl >> 10, ct = (tl >> 6) & 15, nt = tl & 63, c16 = lane & 15, hq = lane >> 4;
                f32x4 acc = {0.f, 0.f, 0.f, 0.f};
#pragma unroll
                for (int ks = 0; ks < 4; ++ks) {
                    const float* ap = wuv + (size_t)(ct * 16 + c16) * 1024 + h * 128 + 32 * ks + 8 * hq; const float* bp = wout + (size_t)(h * 128 + 32 * ks + 8 * hq) * 1024 + nt * 16 + c16;
                    f32x4 b0, b1; b0[0] = bp[0]; b0[1] = bp[1024]; b0[2] = bp[2048]; b0[3] = bp[3072]; b1[0] = bp[4096]; b1[1] = bp[5120]; b1[2] = bp[6144]; b1[3] = bp[7168];
                    acc = mfma16(pack8(*(const f32x4*)ap, *(const f32x4*)(ap + 4)), pack8(b0, b1), acc); }
                u32x2 o; o.x = pk2(acc[0], acc[1]); o.y = pk2(acc[2], acc[3]);
                *(u32x2*)(WF + (size_t)(nt * 16 + c16) * 2048 + h * 256 + ct * 16 + 4 * hq) = o;
            }
        }
    }
    const float* x = (const float*)a.in[0]; bf16_t* HB = (bf16_t*)(a.ws + WS_HB);
    for (int row = gw; row < M; row += nw) {
#pragma unroll
        for (int i = 0; i < 4; ++i) { const size_t o = (size_t)row * D + i * 256 + lane * 4; const f32x4 v = *(const f32x4*)(x + o); u32x2 w; w.x = pk2(v[0], v[1]); w.y = pk2(v[2], v[3]); *(u32x2*)(HB + o) = w; }
    }
}

__device__ __forceinline__ void ln_pass(const float* H, const float* g, const float* bta, bf16_t* HB, const float* p, bf16_t* Pb, float* ST) {
    const int tid = opaque_tid(), lane = tid & 63, gw = blockIdx.x * 8 + (tid >> 6), nw = gridDim.x * 8;
    f32x4 gv[4], bv[4];
#pragma unroll
    for (int i = 0; i < 4; ++i) { gv[i] = *(const f32x4*)(g + i * 256 + lane * 4); bv[i] = *(const f32x4*)(bta + i * 256 + lane * 4); }
    for (int row = gw; row < M; row += nw) {
        f32x4 v[4]; float s = 0.f;
#pragma unroll
        for (int i = 0; i < 4; ++i) { v[i] = *(const f32x4*)(H + (size_t)row * D + i * 256 + lane * 4); s += (v[i][0] + v[i][1]) + (v[i][2] + v[i][3]); }
        const float mu = wave_sum(s) * (1.0f / 1024.0f); float q = 0.f;
#pragma unroll
        for (int i = 0; i < 4; ++i) { v[i] = v[i] - mu; q += (v[i][0] * v[i][0] + v[i][1] * v[i][1]) + (v[i][2] * v[i][2] + v[i][3] * v[i][3]); }
        const float rs = rsqrtf(wave_sum(q) * (1.0f / 1024.0f) + LN_EPS);
#pragma unroll
        for (int i = 0; i < 4; ++i) { const f32x4 y = v[i] * rs * gv[i] + bv[i]; const size_t o = (size_t)row * D + i * 256 + lane * 4; u32x2 w; w.x = pk2(y[0], y[1]); w.y = pk2(y[2], y[3]); *(u32x2*)(HB + o) = w; }
        if (lane == 0) { ST[2 * row] = mu; ST[2 * row + 1] = rs; }
        if (p) { const f32x4 pv = *(const f32x4*)(p + (size_t)row * 256 + lane * 4); u32x2 w; w.x = pk2(pv[0], pv[1]); w.y = pk2(pv[2], pv[3]); *(u32x2*)(Pb + (size_t)row * 256 + lane * 4) = w; }
    }
}
__device__ __forceinline__ void compress_unit(const KArgs& a, int j, LAS uchar* lds, int unit, const bf16_t* Z, const bf16_t* sl, bf16_t* KC, bf16_t* VC) {
    const int tid = opaque_tid(), lane = tid & 63, w = __builtin_amdgcn_readfirstlane(tid >> 6), c16 = lane & 15, hq = lane >> 4;
    const int jk = unit >> 8, b = (unit >> 5) & 7, g = (unit >> 4) & 1, mt = unit & 15;
    const int zc = (jk ? C_BVC : C_BKC) + g * 64;
    const float* pos = (const float*)a.in[8] + (size_t)(j * 2 + jk) * 32 * 64;
    const bf16_t* W1 = sl + OCW1 + (size_t)jk * 128 * 2048; const bf16_t* W2 = sl + OCW2 + (size_t)jk * 64 * 128;
    int m = mt * 16 + c16; if (m > 254) m = 254;
    f32x4 acc = {0.f, 0.f, 0.f, 0.f};
    for (int k0 = 0; k0 < 64; k0 += 4) {
        u32x4 zz[4]; f32x4 pp0[4], pp1[4]; bf16x8 bb[4];
#pragma unroll
        for (int u = 0; u < 4; ++u) { const int ks = k0 + u, l = ks >> 1, d0 = (ks & 1) * 32 + 8 * hq;
            zz[u] = *(const u32x4*)(Z + (size_t)(b * T + m * 16 + l) * ZE + zc + d0);
            pp0[u] = *(const f32x4*)(pos + l * 64 + d0); pp1[u] = *(const f32x4*)(pos + l * 64 + d0 + 4);
            bb[u] = gldv(W1 + (size_t)(16 * w + c16) * 2048 + 32 * ks + 8 * hq); }
#pragma unroll
        for (int u = 0; u < 4; ++u) { const u32x4 z = zz[u]; const f32x4 p0 = pp0[u], p1 = pp1[u];
            u32x4 aw; aw.x = pk2(bflo(z.x) + p0[0], bfhi(z.x) + p0[1]); aw.y = pk2(bflo(z.y) + p0[2], bfhi(z.y) + p0[3]); aw.z = pk2(bflo(z.z) + p1[0], bfhi(z.z) + p1[1]); aw.w = pk2(bflo(z.w) + p1[2], bfhi(z.w) + p1[3]);
            acc = mfma16(__builtin_bit_cast(bf16x8, aw), bb[u], acc); }
    }
    LAS bf16_t* Hc = (LAS bf16_t*)lds;
#pragma unroll
    for (int r = 0; r < 4; ++r) { const float x = acc[r]; const float u = 0.7978845608028654f * (x + 0.044715f * x * x * x); const float th = 1.0f - 2.0f / (1.0f + __expf(2.0f * u)); Hc[(4 * hq + r) * 136 + 16 * w + c16] = (bf16_t)f2bf(0.5f * x * (1.0f + th)); }
    WG_SYNC();
    if (w < 4) {
        f32x4 o = {0.f, 0.f, 0.f, 0.f};
#pragma unroll
        for (int ks = 0; ks < 4; ++ks) o = mfma16(ldsv(lds + (c16 * 136 + 32 * ks + 8 * hq) * 2), gldv(W2 + (size_t)(16 * w + c16) * 128 + 32 * ks + 8 * hq), o);
        bf16_t* dst = (jk ? VC : KC) + (size_t)((b * 2 + g) * 256 + mt * 16) * 64;
#pragma unroll
        for (int r = 0; r < 4; ++r) dst[(4 * hq + r) * 64 + 16 * w + c16] = (bf16_t)f2bf(o[r]);
    }
    WG_SYNC();
}

struct MlBuf { bf16_t* U; float* NH; float* AC; float* BL; float* MC; };

__device__ __forceinline__ void mlstmA_unit(const KArgs& a, int j, LAS uchar* lds, int unit, const bf16_t* Z, const MlBuf& mb) {
    const int tid = opaque_tid(), lane = tid & 63, w = __builtin_amdgcn_readfirstlane(tid >> 6), c16 = lane & 15, hq = lane >> 4;
    const int bh = unit >> 6, c = unit & 63, b = bh >> 2, h = bh & 3;
    constexpr int KI = 0, VW = 17408, GA = 36864, GX = 37120, CW = 37376;
    LAS float* gA = (LAS float*)(lds + GA); LAS float* gX = (LAS float*)(lds + GX); LAS float* cwL = (LAS float*)(lds + CW);
    const float* cw = (const float*)a.in[4] + (size_t)j * 4 * 1024;
    { const int tap = tid >> 7, ch = tid & 127; cwL[tid] = cw[tap * 1024 + 512 + h * 128 + ch]; }
    const int t = tid >> 3, cg8 = tid & 7;
    if (w == 0) {
        const size_t row = (size_t)(b * T + c * 64 + lane);
        const float ig = bf2f(Z[row * ZE + C_AI + h]) + ((const float*)a.in[5])[j * 4 + h], fg = bf2f(Z[row * ZE + C_AF + h]) + ((const float*)a.in[6])[j * 4 + h];
        const float lf = fminf(fg, 0.f) - log1pf(__expf(-fabsf(fg)));
        float bs = lf;
#pragma unroll
        for (int o = 1; o < 64; o <<= 1) { const float t2 = __shfl_up(bs, o); if (lane >= o) bs += t2; }
        const float av = ig - bs; float mx = av;
#pragma unroll
        for (int o = 32; o; o >>= 1) mx = fmaxf(mx, __shfl_xor(mx, o));
        gA[lane] = av; if (lane == 63) { gX[0] = mx; gX[1] = bs; mb.AC[bh * 64 + c] = mx; mb.BL[bh * 64 + c] = bs; }
    }
    u32x4 xz[2][4];
#pragma unroll
    for (int g2 = 0; g2 < 2; ++g2)
#pragma unroll
        for (int tap = 0; tap < 4; ++tap) { const int tt = c * 64 + t - 3 + tap; xz[g2][tap] = (u32x4){0u, 0u, 0u, 0u}; if (tt >= 0) xz[g2][tap] = *(const u32x4*)(Z + (size_t)(b * T + tt) * ZE + C_AK + h * 128 + g2 * 64 + cg8 * 8); }
    const u32x4 v0 = *(const u32x4*)(Z + (size_t)(b * T + c * 64 + t) * ZE + C_AV + h * 128 + cg8 * 16), v1 = *(const u32x4*)(Z + (size_t)(b * T + c * 64 + t) * ZE + C_AV + h * 128 + cg8 * 16 + 8);
    WG_SYNC();
#pragma unroll
    for (int g2 = 0; g2 < 2; ++g2) {
        const int d = g2 * 64 + cg8 * 8; float acc[8];
#pragma unroll
        for (int i = 0; i < 8; ++i) acc[i] = 0.f;
#pragma unroll
        for (int tap = 0; tap < 4; ++tap) { const u32x4 x = xz[g2][tap]; const f32x4 w0 = *(const LAS f32x4*)(cwL + tap * 128 + d), w1 = *(const LAS f32x4*)(cwL + tap * 128 + d + 4);
            acc[0] += w0[0] * bflo(x.x); acc[1] += w0[1] * bfhi(x.x); acc[2] += w0[2] * bflo(x.y); acc[3] += w0[3] * bfhi(x.y);
            acc[4] += w1[0] * bflo(x.z); acc[5] += w1[1] * bfhi(x.z); acc[6] += w1[2] * bflo(x.w); acc[7] += w1[3] * bfhi(x.w); }
#pragma unroll
        for (int i = 0; i < 8; ++i) acc[i] = acc[i] * sigmoidf_(acc[i]);
        u32x4 o; o.x = pk2(acc[0], acc[1]); o.y = pk2(acc[2], acc[3]); o.z = pk2(acc[4], acc[5]); o.w = pk2(acc[6], acc[7]);
        *(LAS u32x4*)(lds + KI + t * 272 + d * 2) = o;
    }
    {   const float ws = __expf(gA[t] - gX[0]);
        u32x4 o0, o1;
        o0.x = pk2(bflo(v0.x) * ws, bfhi(v0.x) * ws); o0.y = pk2(bflo(v0.y) * ws, bfhi(v0.y) * ws); o0.z = pk2(bflo(v0.z) * ws, bfhi(v0.z) * ws); o0.w = pk2(bflo(v0.w) * ws, bfhi(v0.w) * ws);
        o1.x = pk2(bflo(v1.x) * ws, bfhi(v1.x) * ws); o1.y = pk2(bflo(v1.y) * ws, bfhi(v1.y) * ws); o1.z = pk2(bflo(v1.z) * ws, bfhi(v1.z) * ws); o1.w = pk2(bflo(v1.w) * ws, bfhi(v1.w) * ws);
        *(LAS u32x4*)(lds + VW + t * 304 + cg8 * 32) = o0; *(LAS u32x4*)(lds + VW + t * 304 + cg8 * 32 + 16) = o1;
        if (cg8 == 0) { unsigned zero = 0u; asm volatile("" : "+v"(zero)); u32x4 e; e.x = pk2(ws, 0.f); e.y = zero; e.z = zero; e.w = zero; u32x4 z4; z4.x = zero; z4.y = zero; z4.z = zero; z4.w = zero;
            *(LAS u32x4*)(lds + VW + t * 304 + 256) = e; *(LAS u32x4*)(lds + VW + t * 304 + 272) = z4; } }
    WG_SYNC();
    f32x4 acc[9];
#pragma unroll
    for (int vt = 0; vt < 9; ++vt) acc[vt] = (f32x4){0.f, 0.f, 0.f, 0.f};
#pragma unroll
    for (int ks = 0; ks < 2; ++ks) {
        const int r0 = 32 * ks + 4 * hq + (c16 >> 2), cofs = 4 * (c16 & 3);
        const bf16x8 A = cat4(tr16(lds + KI + r0 * 272 + (16 * w + cofs) * 2), tr16(lds + KI + (r0 + 16) * 272 + (16 * w + cofs) * 2));
#pragma unroll
        for (int vt = 0; vt < 9; ++vt) { const bf16x8 B = cat4(tr16(lds + VW + r0 * 304 + (16 * vt + cofs) * 2), tr16(lds + VW + (r0 + 16) * 304 + (16 * vt + cofs) * 2)); acc[vt] = mfma16(A, B, acc[vt]); }
    }
    bf16_t* U = mb.U + (size_t)(bh * 64 + c) * 16384;
#pragma unroll
    for (int vt = 0; vt < 8; ++vt) { u32x2 wv; wv.x = pk2(acc[vt][0], acc[vt][1]); wv.y = pk2(acc[vt][2], acc[vt][3]); *(u32x2*)(U + (size_t)(16 * vt + c16) * 128 + 16 * w + 4 * hq) = wv; }
    if (c16 == 0) *(f32x4*)(mb.NH + (size_t)(bh * 64 + c) * 128 + 16 * w + 4 * hq) = acc[8];
    WG_SYNC();
}

__device__ __forceinline__ void mlstm_scan(const MlBuf& mb) {
    const int tid = opaque_tid(); const int gid = blockIdx.x * NTHR + tid, nthr = gridDim.x * NTHR;
    for (int e = gid; e < 32 * 4096; e += nthr) {
        const int bh = e >> 12, eg = e & 4095;
        bf16_t* U = mb.U + (size_t)bh * 64 * 16384 + eg * 4;
        float st[4] = {0.f, 0.f, 0.f, 0.f}, sn[4] = {0.f, 0.f, 0.f, 0.f}, m = 0.f;
        for (int c0 = 0; c0 < 64; c0 += 8) {
            u32x2 u[8]; f32x4 nh[8]; float Ac[8], Bl[8];
#pragma unroll
            for (int k = 0; k < 8; ++k) { u[k] = *(const u32x2*)(U + (size_t)(c0 + k) * 16384); Ac[k] = mb.AC[bh * 64 + c0 + k]; Bl[k] = mb.BL[bh * 64 + c0 + k];
                nh[k] = (f32x4){0.f, 0.f, 0.f, 0.f}; if (eg < 32) nh[k] = *(const f32x4*)(mb.NH + (size_t)(bh * 64 + c0 + k) * 128 + eg * 4); }
#pragma unroll
            for (int k = 0; k < 8; ++k) {
                u32x2 o; o.x = pk2(st[0], st[1]); o.y = pk2(st[2], st[3]); *(u32x2*)(U + (size_t)(c0 + k) * 16384) = o;
                if (eg < 32) *(f32x4*)(mb.NH + (size_t)(bh * 64 + c0 + k) * 128 + eg * 4) = (f32x4){sn[0], sn[1], sn[2], sn[3]};
                if (eg == 0) mb.MC[bh * 64 + c0 + k] = m;
                const float Mx = fmaxf(m, Ac[k]), e1 = __expf(m - Mx), e2 = __expf(Ac[k] - Mx);
                st[0] = e1 * st[0] + e2 * bflo(u[k].x); st[1] = e1 * st[1] + e2 * bfhi(u[k].x); st[2] = e1 * st[2] + e2 * bflo(u[k].y); st[3] = e1 * st[3] + e2 * bfhi(u[k].y);
#pragma unroll
                for (int i = 0; i < 4; ++i) sn[i] = e1 * sn[i] + e2 * nh[k][i];
                m = Bl[k] + Mx;
            }
        }
    }
}

__device__ __forceinline__ void mlstmC_unit(const KArgs& a, int j, LAS uchar* lds, int unit, const bf16_t* Z, bf16_t* Y, const MlBuf& mb) {
    const int tid = opaque_tid(), lane = tid & 63, w = __builtin_amdgcn_readfirstlane(tid >> 6), c16 = lane & 15, hq = lane >> 4;
    GAS const bf16_t* Zg = (GAS const bf16_t*)Z; GAS bf16_t* Yg = (GAS bf16_t*)Y;
    const int bh = unit >> 6, c = unit & 63, b = bh >> 2, h = bh & 3;
    constexpr int QI = 0, KI = 17408, VN = 34816, SG = 54272, HC = 63488, GA = 97280, GM = 97536, GB = 97792, CW = 98304;
    LAS float* gA = (LAS float*)(lds + GA); LAS float* gM = (LAS float*)(lds + GM); LAS float* gB = (LAS float*)(lds + GB); LAS float* cwL = (LAS float*)(lds + CW);
    LAS float* hcL = (LAS float*)(lds + HC);
    const float* cw = (const float*)a.in[4] + (size_t)j * 4 * 1024;
    for (int i = tid; i < 1024; i += NTHR) { const int tap = i >> 8, ch = i & 255; cwL[i] = cw[tap * 1024 + (ch >> 7) * 512 + h * 128 + (ch & 127)]; }
    const float m_c = mb.MC[bh * 64 + c];
    const int t = tid >> 3, cg8 = tid & 7;
    if (w == 0) {
        const size_t row = (size_t)(b * T + c * 64 + lane);
        const float ig = bf2f(Zg[row * ZE + C_AI + h]) + ((const float*)a.in[5])[j * 4 + h], fg = bf2f(Zg[row * ZE + C_AF + h]) + ((const float*)a.in[6])[j * 4 + h];
        const float lf = fminf(fg, 0.f) - log1pf(__expf(-fabsf(fg)));
        float bs = lf;
#pragma unroll
        for (int o = 1; o < 64; o <<= 1) { const float t2 = __shfl_up(bs, o); if (lane >= o) bs += t2; }
        const float av = ig - bs; float pm = av;
#pragma unroll
        for (int o = 1; o < 64; o <<= 1) { const float t2 = __shfl_up(pm, o); if (lane >= o) pm = fmaxf(pm, t2); }
        gA[lane] = av; gM[lane] = fmaxf(m_c, pm); gB[lane] = bs;
    }
    u32x4 xz[4][4];
#pragma unroll
    for (int g4 = 0; g4 < 4; ++g4) { const int ch = g4 * 64 + cg8 * 8, zc = ((ch >> 7) ? C_AK : C_AQ) + h * 128 + (ch & 127);
#pragma unroll
        for (int tap = 0; tap < 4; ++tap) { const int tt = c * 64 + t - 3 + tap; xz[g4][tap] = (u32x4){0u, 0u, 0u, 0u}; if (tt >= 0) xz[g4][tap] = *(GAS const u32x4*)(Zg + (size_t)(b * T + tt) * ZE + zc); } }
    {   GAS const bf16_t* vp = Zg + (size_t)(b * T + c * 64 + t) * ZE + C_AV + h * 128 + cg8 * 16;
        *(LAS u32x4*)(lds + VN + t * 304 + cg8 * 32) = *(GAS const u32x4*)vp; *(LAS u32x4*)(lds + VN + t * 304 + cg8 * 32 + 16) = *(GAS const u32x4*)(vp + 8);
        if (cg8 == 0) { unsigned one = 0x3F80u, zero = 0u; asm volatile("" : "+v"(one), "+v"(zero)); u32x4 e; e.x = one; e.y = zero; e.z = zero; e.w = zero; u32x4 z4; z4.x = zero; z4.y = zero; z4.z = zero; z4.w = zero;
            *(LAS u32x4*)(lds + VN + t * 304 + 256) = e; *(LAS u32x4*)(lds + VN + t * 304 + 272) = z4; } }
    WG_SYNC();
#pragma unroll
    for (int g4 = 0; g4 < 4; ++g4) {
        const int ch = g4 * 64 + cg8 * 8, isk = ch >> 7, d = ch & 127; float acc[8];
#pragma unroll
        for (int i = 0; i < 8; ++i) acc[i] = 0.f;
#pragma unroll
        for (int tap = 0; tap < 4; ++tap) { const u32x4 x = xz[g4][tap]; const f32x4 w0 = *(const LAS f32x4*)(cwL + tap * 256 + ch), w1 = *(const LAS f32x4*)(cwL + tap * 256 + ch + 4);
            acc[0] += w0[0] * bflo(x.x); acc[1] += w0[1] * bfhi(x.x); acc[2] += w0[2] * bflo(x.y); acc[3] += w0[3] * bfhi(x.y);
            acc[4] += w1[0] * bflo(x.z); acc[5] += w1[1] * bfhi(x.z); acc[6] += w1[2] * bflo(x.w); acc[7] += w1[3] * bfhi(x.w); }
        const float sc = isk ? 1.0f : 0.08838834764831845f;
#pragma unroll
        for (int i = 0; i < 8; ++i) acc[i] = acc[i] * sigmoidf_(acc[i]) * sc;
        u32x4 o; o.x = pk2(acc[0], acc[1]); o.y = pk2(acc[2], acc[3]); o.z = pk2(acc[4], acc[5]); o.w = pk2(acc[6], acc[7]);
        *(LAS u32x4*)(lds + (isk ? KI : QI) + t * 272 + d * 2) = o;
    }
    WG_SYNC();
    {
        const int ti = w >> 1;
#pragma unroll
        for (int sjj = 0; sjj < 2; ++sjj) {
            const int sj = (w & 1) * 2 + sjj; f32x4 acc = {0.f, 0.f, 0.f, 0.f};
            if (sj <= ti) {
#pragma unroll
                for (int ks = 0; ks < 4; ++ks) acc = mfma16(ldsv(lds + QI + (16 * ti + c16) * 272 + (32 * ks + 8 * hq) * 2), ldsv(lds + KI + (16 * sj + c16) * 272 + (32 * ks + 8 * hq) * 2), acc);
            }
            const int s = 16 * sj + c16; const float as = gA[s];
#pragma unroll
            for (int r = 0; r < 4; ++r) { const int tt = 16 * ti + 4 * hq + r; const float val = (s <= tt) ? acc[r] * __expf(as - gM[tt]) : 0.f; ((LAS bf16_t*)(lds + SG))[tt * 72 + s] = (bf16_t)f2bf(val); }
        }
    }
    WG_SYNC();
    {
        const int tt = w & 3, vh = w >> 2;
        GAS const bf16_t* Cg = (GAS const bf16_t*)mb.U + (size_t)(bh * 64 + c) * 16384; GAS const float* ng = (GAS const float*)mb.NH + (size_t)(bh * 64 + c) * 128;
        f32x4 n[4], nd = {0.f, 0.f, 0.f, 0.f};
#pragma unroll
        for (int v4 = 0; v4 < 4; ++v4) n[v4] = (f32x4){0.f, 0.f, 0.f, 0.f};
#pragma unroll
        for (int ks = 0; ks < 4; ++ks) { const bf16x8 A = ldsv(lds + QI + (16 * tt + c16) * 272 + (32 * ks + 8 * hq) * 2);
#pragma unroll
            for (int v4 = 0; v4 < 4; ++v4) n[v4] = mfma16(A, gldvg(Cg + (size_t)(16 * (4 * vh + v4) + c16) * 128 + 32 * ks + 8 * hq), n[v4]);
            u32x4 nb = {0u, 0u, 0u, 0u};
            if (c16 == 0) { const f32x4 n0 = *(GAS const f32x4*)(ng + 32 * ks + 8 * hq), n1 = *(GAS const f32x4*)(ng + 32 * ks + 8 * hq + 4); nb.x = pk2(n0[0], n0[1]); nb.y = pk2(n0[2], n0[3]); nb.z = pk2(n1[0], n1[1]); nb.w = pk2(n1[2], n1[3]); }
            nd = mfma16(A, __builtin_bit_cast(bf16x8, nb), nd); }
#pragma unroll
        for (int r = 0; r < 4; ++r) { const float e = __expf(m_c - gM[16 * tt + 4 * hq + r]);
#pragma unroll
            for (int v4 = 0; v4 < 4; ++v4) n[v4][r] *= e;
            nd[r] *= e; }
#pragma unroll
        for (int ks = 0; ks < 2; ++ks) {
            const bf16x8 A = cat4(*(const LAS s16x4*)(lds + SG + (16 * tt + c16) * 144 + (32 * ks + 4 * hq) * 2), *(const LAS s16x4*)(lds + SG + (16 * tt + c16) * 144 + (32 * ks + 16 + 4 * hq) * 2));
            const int r0 = 32 * ks + 4 * hq + (c16 >> 2), cofs = 4 * (c16 & 3);
#pragma unroll
            for (int v4 = 0; v4 < 4; ++v4) { const int vt = 4 * vh + v4; n[v4] = mfma16(A, cat4(tr16(lds + VN + r0 * 304 + (16 * vt + cofs) * 2), tr16(lds + VN + (r0 + 16) * 304 + (16 * vt + cofs) * 2)), n[v4]); }
            nd = mfma16(A, cat4(tr16(lds + VN + r0 * 304 + (128 + cofs) * 2), tr16(lds + VN + (r0 + 16) * 304 + (128 + cofs) * 2)), nd); }
#pragma unroll
        for (int r = 0; r < 4; ++r) { const int tr_ = 16 * tt + 4 * hq + r; const float den = __shfl(nd[r], lane & 48); const float lim = __expf(-(gB[tr_] + gM[tr_]));
            const float dv = 1.0f / fmaxf(fabsf(den), lim);
#pragma unroll
            for (int v4 = 0; v4 < 4; ++v4) hcL[tr_ * 132 + 16 * (4 * vh + v4) + c16] = n[v4][r] * dv; }
    }
    WG_SYNC();
    {
        const size_t row = (size_t)(b * T + c * 64 + t);
        float x[16]; float s = 0.f;
#pragma unroll
        for (int i = 0; i < 4; ++i) { const f32x4 v = *(const LAS f32x4*)(hcL + t * 132 + cg8 * 16 + 4 * i); x[4 * i] = v[0]; x[4 * i + 1] = v[1]; x[4 * i + 2] = v[2]; x[4 * i + 3] = v[3]; s += (v[0] + v[1]) + (v[2] + v[3]); }
        s += __shfl_xor(s, 1); s += __shfl_xor(s, 2); s += __shfl_xor(s, 4);
        const float mu = s * (1.0f / 128.0f); float q = 0.f;
#pragma unroll
        for (int i = 0; i < 16; ++i) { x[i] -= mu; q += x[i] * x[i]; }
        q += __shfl_xor(q, 1); q += __shfl_xor(q, 2); q += __shfl_xor(q, 4);
        const float rs = rsqrtf(q * (1.0f / 128.0f) + LN_EPS);
        const float* ng = (const float*)a.in[7] + (size_t)j * 512 + h * 128 + cg8 * 16;
        const u32x4 o0 = *(GAS const u32x4*)(Zg + row * ZE + C_AO + h * 128 + cg8 * 16), o1 = *(GAS const u32x4*)(Zg + row * ZE + C_AO + h * 128 + cg8 * 16 + 8);
        const float ov[16] = {bflo(o0.x), bfhi(o0.x), bflo(o0.y), bfhi(o0.y), bflo(o0.z), bfhi(o0.z), bflo(o0.w), bfhi(o0.w), bflo(o1.x), bfhi(o1.x), bflo(o1.y), bfhi(o1.y), bflo(o1.z), bfhi(o1.z), bflo(o1.w), bfhi(o1.w)};
        float y[16];
#pragma unroll
        for (int i = 0; i < 16; ++i) y[i] = x[i] * rs * ng[i] * sigmoidf_(ov[i]);
        u32x4 w0, w1; w0.x = pk2(y[0], y[1]); w0.y = pk2(y[2], y[3]); w0.z = pk2(y[4], y[5]); w0.w = pk2(y[6], y[7]); w1.x = pk2(y[8], y[9]); w1.y = pk2(y[10], y[11]); w1.z = pk2(y[12], y[13]); w1.w = pk2(y[14], y[15]);
        *(GAS u32x4*)(Yg + row * D + h * 128 + cg8 * 16) = w0; *(GAS u32x4*)(Yg + row * D + h * 128 + cg8 * 16 + 8) = w1;
    }
    WG_SYNC();
}

__device__ __forceinline__ void stage64(LAS uchar* dst, const bf16_t* src, size_t ld) { const int tid = opaque_tid(), row = tid >> 3, ch = tid & 7; *(LAS u32x4*)(dst + row * 144 + ch * 16) = *(const u32x4*)(src + (size_t)row * ld + ch * 8); }

template <int MODE>
__device__ __forceinline__ void nsa_tile(LAS const uchar* Kt, LAS const uchar* Vt, const bf16x8 (&qf)[2][2], float (&mr)[2], float (&lr)[2], f32x4 (&o)[2][4],
                                         int tile, const int (&tq)[2], const unsigned (&selw)[2], LAS float* IMP, int w, int lane) {
    const int c16 = lane & 15, hq = lane >> 4;
    if (MODE == 2) { if (__ballot((selw[0] | selw[1]) != 0u) == 0ull) return; }
    f32x4 s[2][4];
#pragma unroll
    for (int kt = 0; kt < 4; ++kt) { const bf16x8 A0 = ldsv(Kt + (16 * kt + c16) * 144 + 16 * hq), A1 = ldsv(Kt + (16 * kt + c16) * 144 + 64 + 16 * hq);
#pragma unroll
        for (int qt = 0; qt < 2; ++qt) { f32x4 z = {0.f, 0.f, 0.f, 0.f}; z = mfma16(A0, qf[qt][0], z); s[qt][kt] = mfma16(A1, qf[qt][1], z); } }
#pragma unroll
    for (int qt = 0; qt < 2; ++qt) {
        unsigned vm = 0; float mx = NEGF;
        const int tqlo = (tq[qt] & ~63) + 8 * w, tqhi = tqlo + 7;
        bool full = false;
        if (MODE == 2) full = (tile * 64 + 63 <= tqlo);
        if (MODE == 3) full = (tile * 64 + 63 <= tqlo) && (tile * 64 > tqhi - 512);
        if (full) {
            vm = (MODE == 2) ? (selw[qt] ? 0xFFFFu : 0u) : 0xFFFFu;
            if (vm) {
#pragma unroll
                for (int kt = 0; kt < 4; ++kt) mx = fmaxf(fmaxf(mx, fmaxf(s[qt][kt][0], s[qt][kt][1])), fmaxf(s[qt][kt][2], s[qt][kt][3])); }
        } else {
#pragma unroll
        for (int kt = 0; kt < 4; ++kt)
#pragma unroll
            for (int r = 0; r < 4; ++r) { const int key = tile * 64 + 16 * kt + 4 * hq + r; bool v;
                if (MODE <= 1) v = (16 * key + 31 <= tq[qt]) && (key < 255);
                else if (MODE == 2) v = (selw[qt] != 0u) && (key <= tq[qt]);
                else v = (key <= tq[qt]) && (key > tq[qt] - 512);
                if (v) { vm |= 1u << (kt * 4 + r); mx = fmaxf(mx, s[qt][kt][r]); } }
        }
        if (MODE != 1) {
            mx = fmaxf(mx, __shfl_xor(mx, 16)); mx = fmaxf(mx, __shfl_xor(mx, 32));
            const float mnew = fmaxf(mr[qt], mx), alpha = __expf(mr[qt] - mnew); float sum = 0.f;
#pragma unroll
            for (int kt = 0; kt < 4; ++kt)
#pragma unroll
                for (int r = 0; r < 4; ++r) { const float p = ((vm >> (kt * 4 + r)) & 1u) ? __expf(s[qt][kt][r] - mnew) : 0.f; s[qt][kt][r] = p; sum += p; }
            sum += __shfl_xor(sum, 16); sum += __shfl_xor(sum, 32);
            lr[qt] = lr[qt] * alpha + sum; mr[qt] = mnew;
            if (MODE != 0) {
#pragma unroll
                for (int dt = 0; dt < 4; ++dt) o[qt][dt] = o[qt][dt] * alpha; }
        } else {
            const float mfin = mr[qt], inv = lr[qt] > 0.f ? 1.0f / lr[qt] : 0.f;
#pragma unroll
            for (int kt = 0; kt < 4; ++kt) {
#pragma unroll
                for (int r = 0; r < 4; ++r) s[qt][kt][r] = ((vm >> (kt * 4 + r)) & 1u) ? __expf(s[qt][kt][r] - mfin) * inv : 0.f;
                float own = (s[qt][kt][0] + s[qt][kt][1]) + (s[qt][kt][2] + s[qt][kt][3]), nb = s[qt][kt][3];
                own += __shfl_xor(own, 1); own += __shfl_xor(own, 2); nb += __shfl_xor(nb, 1); nb += __shfl_xor(nb, 2);
                if ((c16 & 3) == 0) { const int q = 8 * w + 4 * qt + (c16 >> 2), jb = 16 * tile + 4 * kt + hq;
                    __hip_atomic_fetch_add(IMP + q * 64 + jb, own, __ATOMIC_RELAXED, __HIP_MEMORY_SCOPE_WORKGROUP);
                    if (jb < 63) __hip_atomic_fetch_add(IMP + q * 64 + jb + 1, nb, __ATOMIC_RELAXED, __HIP_MEMORY_SCOPE_WORKGROUP); }
            }
        }
    }
    if (MODE != 0) {
#pragma unroll
        for (int k2 = 0; k2 < 2; ++k2) {
            bf16x8 B[2];
#pragma unroll
            for (int qt = 0; qt < 2; ++qt) B[qt] = pack8(s[qt][2 * k2], s[qt][2 * k2 + 1]);
#pragma unroll
            for (int dt = 0; dt < 4; ++dt) {
                const s16x4 lo = tr16(Vt + (32 * k2 + 4 * hq + (c16 >> 2)) * 144 + (16 * dt + 4 * (c16 & 3)) * 2), hi = tr16(Vt + (32 * k2 + 16 + 4 * hq + (c16 >> 2)) * 144 + (16 * dt + 4 * (c16 & 3)) * 2);
                const bf16x8 A = cat4(lo, hi);
#pragma unroll
                for (int qt = 0; qt < 2; ++qt) o[qt][dt] = mfma16(A, B[qt], o[qt][dt]);
            }
        }
    }
}

template <int MODE>
__device__ __forceinline__ void nsa_sweep(LAS uchar* lds, unsigned long long msk, const bf16_t* Kb, const bf16_t* Vb, size_t step, size_t ld,
                                          const bf16x8 (&qf)[2][2], float (&mr)[2], float (&lr)[2], f32x4 (&o)[2][4], const int (&tq)[2], LAS const unsigned* SELM, LAS float* IMP, int w, int lane) {
    const int tid = opaque_tid(), row = tid >> 3, ch = tid & 7, c16 = lane & 15;
    if (msk == 0ull) return;
    GAS const bf16_t* Kg = (GAS const bf16_t*)Kb; GAS const bf16_t* Vg = (GAS const bf16_t*)Vb;
    constexpr int K0 = 0, V0 = 9216, K1 = 36864, V1 = 46080;
    int t0 = __ffsll((long long)msk) - 1; msk &= msk - 1ull;
    int t1 = msk ? (__ffsll((long long)msk) - 1) : -1; if (t1 >= 0) msk &= msk - 1ull;
    u32x4 rk0 = *(GAS const u32x4*)(Kg + (size_t)t0 * step + (size_t)row * ld + ch * 8), rv0 = rk0, rk1 = rk0, rv1 = rk0;
    if (MODE != 0) rv0 = *(GAS const u32x4*)(Vg + (size_t)t0 * step + (size_t)row * ld + ch * 8);
    if (t1 >= 0) { rk1 = *(GAS const u32x4*)(Kg + (size_t)t1 * step + (size_t)row * ld + ch * 8); if (MODE != 0) rv1 = *(GAS const u32x4*)(Vg + (size_t)t1 * step + (size_t)row * ld + ch * 8); }
    while (true) {
        *(LAS u32x4*)(lds + K0 + row * 144 + ch * 16) = rk0; if (MODE != 0) *(LAS u32x4*)(lds + V0 + row * 144 + ch * 16) = rv0;
        if (t1 >= 0) { *(LAS u32x4*)(lds + K1 + row * 144 + ch * 16) = rk1; if (MODE != 0) *(LAS u32x4*)(lds + V1 + row * 144 + ch * 16) = rv1; }
        int n0 = -1, n1 = -1;
        if (msk) { n0 = __ffsll((long long)msk) - 1; msk &= msk - 1ull; if (msk) { n1 = __ffsll((long long)msk) - 1; msk &= msk - 1ull; } }
        unsigned sa[2] = {0u, 0u}, sb[2] = {0u, 0u};
        if (MODE == 2) {
#pragma unroll
            for (int qt = 0; qt < 2; ++qt) { const int q = 8 * w + 4 * qt + (c16 >> 2); sa[qt] = (SELM[q * 2 + (t0 >> 5)] >> (t0 & 31)) & 1u; if (t1 >= 0) sb[qt] = (SELM[q * 2 + (t1 >> 5)] >> (t1 & 31)) & 1u; } }
        WG_SYNC();
        if (n0 >= 0) { rk0 = *(GAS const u32x4*)(Kg + (size_t)n0 * step + (size_t)row * ld + ch * 8); if (MODE != 0) rv0 = *(GAS const u32x4*)(Vg + (size_t)n0 * step + (size_t)row * ld + ch * 8); }
        if (n1 >= 0) { rk1 = *(GAS const u32x4*)(Kg + (size_t)n1 * step + (size_t)row * ld + ch * 8); if (MODE != 0) rv1 = *(GAS const u32x4*)(Vg + (size_t)n1 * step + (size_t)row * ld + ch * 8); }
        nsa_tile<MODE>(lds + K0, lds + V0, qf, mr, lr, o, t0, tq, sa, IMP, w, lane);
        if (t1 >= 0) nsa_tile<MODE>(lds + K1, lds + V1, qf, mr, lr, o, t1, tq, sb, IMP, w, lane);
        WG_SYNC();
        if (n0 < 0) break;
        t0 = n0; t1 = n1;
    }
}

__device__ __forceinline__ void nsa_unit(const KArgs& a, int j, LAS uchar* lds, int b, int g, int qb, const bf16_t* Z, const bf16_t* KC, const bf16_t* VC, bf16_t* Y) {
    const int tid = opaque_tid(), lane = tid & 63, w = __builtin_amdgcn_readfirstlane(tid >> 6), c16 = lane & 15, hq = lane >> 4;
    constexpr int KT_ = 0, VT_ = 9216, IMP_ = 18432, SEL_ = 34816, ANY_ = 35328;
    LAS float* IMP = (LAS float*)(lds + IMP_); LAS unsigned* SELM = (LAS unsigned*)(lds + SEL_); LAS unsigned* ANY = (LAS unsigned*)(lds + ANY_);
    GAS const bf16_t* Zg = (GAS const bf16_t*)Z; GAS bf16_t* Yg = (GAS bf16_t*)Y;
    const int s0 = qb * 64, head = c16 & 3;
    int tq[2]; bf16x8 qf[2][2]; float gt[2][3];
#pragma unroll
    for (int qt = 0; qt < 2; ++qt) {
        tq[qt] = s0 + 8 * w + 4 * qt + (c16 >> 2);
        const size_t row = (size_t)(b * T + tq[qt]);
#pragma unroll
        for (int ks = 0; ks < 2; ++ks) { const u32x4 x = *(GAS const u32x4*)(Zg + row * ZE + C_BQ + (g * 4 + head) * 64 + 32 * ks + 8 * hq);
            u32x4 y; y.x = pk2(bflo(x.x) * 0.125f, bfhi(x.x) * 0.125f); y.y = pk2(bflo(x.y) * 0.125f, bfhi(x.y) * 0.125f); y.z = pk2(bflo(x.z) * 0.125f, bfhi(x.z) * 0.125f); y.w = pk2(bflo(x.w) * 0.125f, bfhi(x.w) * 0.125f);
            qf[qt][ks] = __builtin_bit_cast(bf16x8, y); }
#pragma unroll
        for (int br = 0; br < 3; ++br) gt[qt][br] = sigmoidf_(bf2f(Zg[row * ZE + C_BG + g * 12 + head * 3 + br]) + ((const float*)a.in[11])[j * 24 + g * 12 + head * 3 + br]);
#ifdef PROBE_NSA_BR
        gt[qt][PROBE_NSA_BR] *= (float)(PROBE_NSA_BS);
#endif
    }
    for (int i = tid; i < 4096; i += NTHR) IMP[i] = 0.f;
    if (tid < 128) SELM[tid] = 0u; if (tid < 2) ANY[tid] = 0u;
    float mr[2] = {NEGF, NEGF}, lr[2] = {0.f, 0.f}; f32x4 o[2][4], ot[2][4]; unsigned selw[2] = {0u, 0u};
#pragma unroll
    for (int qt = 0; qt < 2; ++qt)
#pragma unroll
        for (int dt = 0; dt < 4; ++dt) { o[qt][dt] = (f32x4){0.f, 0.f, 0.f, 0.f}; ot[qt][dt] = o[qt][dt]; }
    const bf16_t* kc = KC + (size_t)(b * 2 + g) * 256 * 64; const bf16_t* vc = VC + (size_t)(b * 2 + g) * 256 * 64;
    int ntc = (s0 + 32) / 1024 + 1; if (ntc > 4) ntc = 4;
    WG_SYNC();
    nsa_sweep<0>(lds, (1ull << ntc) - 1ull, kc, vc, (size_t)64 * 64, 64, qf, mr, lr, o, tq, SELM, IMP, w, lane);
    nsa_sweep<1>(lds, (1ull << ntc) - 1ull, kc, vc, (size_t)64 * 64, 64, qf, mr, lr, o, tq, SELM, IMP, w, lane);
#pragma unroll
    for (int qt = 0; qt < 2; ++qt)
#pragma unroll
        for (int dt = 0; dt < 4; ++dt) { ot[qt][dt] = o[qt][dt] * gt[qt][0]; o[qt][dt] = (f32x4){0.f, 0.f, 0.f, 0.f}; }
    {
        const int q = tid >> 3, sub = tid & 7; unsigned bits = 0u;
        if (qb + 1 <= 16) { for (int jj = 0; jj < 8; ++jj) if (sub * 8 + jj <= qb) bits |= 1u << jj; }
        else {
            for (int jj = 0; jj < 8; ++jj) { const int jb = sub * 8 + jj; bool sel = (jb == 0) || (jb == qb) || (jb == qb - 1);
                if (!sel && jb >= 1 && jb <= qb - 2) { const float v = IMP[q * 64 + jb]; int cnt = 0;
                    for (int j2 = 1; j2 <= qb - 2; ++j2) { const float v2 = IMP[q * 64 + j2]; cnt += ((v2 > v) || (v2 == v && j2 < jb)) ? 1 : 0; }
                    sel = cnt < 13; }
                if (sel) bits |= 1u << jj; }
        }
        atomicOr((unsigned*)(SELM + q * 2 + (sub >> 2)), bits << ((sub & 3) * 8)); atomicOr((unsigned*)(ANY + (sub >> 2)), bits << ((sub & 3) * 8));
    }
    WG_SYNC();
    const unsigned any0 = ANY[0], any1 = ANY[1];
    mr[0] = mr[1] = NEGF; lr[0] = lr[1] = 0.f;
    {
        unsigned long long msk = ((unsigned long long)any1 << 32) | (unsigned long long)any0;
        msk &= (qb >= 63) ? ~0ull : ((1ull << (qb + 1)) - 1ull);
        nsa_sweep<2>(lds, msk, Z + (size_t)(b * T) * ZE + C_BKS + g * 64, Z + (size_t)(b * T) * ZE + C_BVS + g * 64, (size_t)64 * ZE, ZE, qf, mr, lr, o, tq, SELM, IMP, w, lane);
#ifdef PROBE_NSA_SEL
        { float mr2[2] = {NEGF, NEGF}, lr2[2] = {0.f, 0.f}; f32x4 o2[2][4];
          for (int qt = 0; qt < 2; ++qt) for (int dt = 0; dt < 4; ++dt) o2[qt][dt] = (f32x4){0.f, 0.f, 0.f, 0.f};
          nsa_sweep<2>(lds, msk, Z + (size_t)(b * T) * ZE + C_BKS + g * 64, Z + (size_t)(b * T) * ZE + C_BVS + g * 64, (size_t)64 * ZE, ZE, qf, mr2, lr2, o2, tq, SELM, IMP, w, lane);
          if (lr2[0] == -1.0f) ot[0][0] = o2[0][0]; }
#endif
    }
#pragma unroll
    for (int qt = 0; qt < 2; ++qt) { const float sc = lr[qt] > 0.f ? gt[qt][1] / lr[qt] : 0.f;
#pragma unroll
        for (int dt = 0; dt < 4; ++dt) { ot[qt][dt] = ot[qt][dt] + o[qt][dt] * sc; o[qt][dt] = (f32x4){0.f, 0.f, 0.f, 0.f}; } }
    mr[0] = mr[1] = NEGF; lr[0] = lr[1] = 0.f;
    {
        const int lo_t = qb > 8 ? qb - 8 : 0;
        unsigned long long msk = (qb >= 63) ? ~0ull : ((1ull << (qb + 1)) - 1ull);
        msk &= ~((1ull << lo_t) - 1ull);
        nsa_sweep<3>(lds, msk, Z + (size_t)(b * T) * ZE + C_BKW + g * 64, Z + (size_t)(b * T) * ZE + C_BVW + g * 64, (size_t)64 * ZE, ZE, qf, mr, lr, o, tq, SELM, IMP, w, lane);
    }
#pragma unroll
    for (int qt = 0; qt < 2; ++qt) { const float sc = lr[qt] > 0.f ? gt[qt][2] / lr[qt] : 0.f;
#pragma unroll
        for (int dt = 0; dt < 4; ++dt) { f32x4 v = ot[qt][dt] + o[qt][dt] * sc;
#ifdef PROBE_NSA_SCALE
            v = v * (float)(PROBE_NSA_SCALE);
#endif
            u32x2 wv; wv.x = pk2(v[0], v[1]); wv.y = pk2(v[2], v[3]);
            *(GAS u32x2*)(Yg + (size_t)(b * T + tq[qt]) * D + 512 + (g * 4 + head) * 64 + 16 * dt + 4 * hq) = wv; } }
    WG_SYNC();
}
#define XB_TMO      128
#define XB_XCNT(j)  (256  + 64 * (j))
#define XB_XSUB(j)  (1280 + 64 * (j))
#define XB_XGEN(j)  (2304 + 64 * (j))
#define XB_TOP      3328
#define XB_TOPGEN   3392
#define XCD_BAR_WORDS 3456
#define XB_SPIN_CAP (1u << 18)

__device__ __forceinline__ unsigned xb_ld(unsigned* p)              { return __hip_atomic_load(p, __ATOMIC_RELAXED, __HIP_MEMORY_SCOPE_AGENT); }
__device__ __forceinline__ unsigned xb_add(unsigned* p, unsigned v) { return __hip_atomic_fetch_add(p, v, __ATOMIC_RELAXED, __HIP_MEMORY_SCOPE_AGENT); }
__device__ __forceinline__ unsigned xb_xcc_id() { return (unsigned)__builtin_amdgcn_s_getreg((3 << 11) | 20) & 0xFu; }
#define XB_SPIN(cond, bar) do { unsigned _sp = 0; while (cond) { __builtin_amdgcn_s_sleep(1); \
    if ((++_sp & 255u) == 0u) { if (xb_ld(&(bar)[XB_TMO])) break; if (_sp > XB_SPIN_CAP) { atomicAdd(&(bar)[XB_TMO], 1u); break; } } } } while (0)

struct XcdBarrier {
    unsigned* bar; unsigned x;
    volatile LAS unsigned* st;
};

__device__ __forceinline__ XcdBarrier xcd_barrier_post(unsigned* bar, volatile LAS unsigned* st) {
    XcdBarrier b; b.bar = bar; b.x = xb_xcc_id(); b.st = st;
    if (threadIdx.x == 0) (void)xb_add(&bar[XB_XCNT(b.x)], 1u);
    return b;
}
__device__ __forceinline__ void xcd_barrier_complete(unsigned* bar, unsigned x, unsigned& nloc, unsigned& nx) {
    const unsigned G = gridDim.x * gridDim.y * gridDim.z;
    unsigned sum, cnt, mine, sp = 0u;
    for (;;) {
        sum = 0u; cnt = 0u; mine = 0u;
#pragma unroll
        for (unsigned j = 0; j < 16; ++j) { const unsigned c = xb_ld(&bar[XB_XCNT(j)]); sum += c; cnt += (c > 0u) ? 1u : 0u; mine = (j == x) ? c : mine; }
        if (sum == G) break;
        __builtin_amdgcn_s_sleep(1);
        if ((++sp & 255u) == 0u) { if (xb_ld(&bar[XB_TMO])) break; if (sp > XB_SPIN_CAP) { atomicAdd(&bar[XB_TMO], 1u); break; } }
    }
    nloc = mine > 0u ? mine : 1u; nx = cnt > 0u ? cnt : 1u;
}

__device__ __forceinline__ void xcd_barrier(const XcdBarrier& b) {
    asm volatile("s_waitcnt vmcnt(0)" ::: "memory");
    __syncthreads();
    if (threadIdx.x == 0) {
        unsigned* bar = b.bar; asm volatile("" : "+s"(bar));
        __builtin_amdgcn_s_waitcnt(0);
        unsigned nloc = b.st[0], nx = b.st[1];
        if (nloc == 0u) { xcd_barrier_complete(bar, b.x, nloc, nx); b.st[0] = nloc; b.st[1] = nx; }
        const unsigned old = xb_add(&bar[XB_XSUB(b.x)], 1u);
        const unsigned gen = old / nloc;
        if (old + 1u == (gen + 1u) * nloc) {
            __builtin_amdgcn_fence(__ATOMIC_RELEASE, "agent");
            asm volatile("s_waitcnt vmcnt(0)" ::: "memory");
            const unsigned og = xb_add(&bar[XB_TOP], 1u);
            const unsigned tg = og / nx;
            if (og + 1u == (tg + 1u) * nx) xb_add(&bar[XB_TOPGEN], 1u);
            else XB_SPIN(xb_ld(&bar[XB_TOPGEN]) == tg, bar);
            __builtin_amdgcn_fence(__ATOMIC_ACQUIRE, "agent");
            xb_add(&bar[XB_XGEN(b.x)], 1u);
            asm volatile("s_waitcnt vmcnt(0)" ::: "memory");
        } else {
            XB_SPIN(xb_ld(&bar[XB_XGEN(b.x)]) == gen, bar);
            __builtin_amdgcn_fence(__ATOMIC_ACQUIRE, "agent");
            asm volatile("s_waitcnt vmcnt(0)" ::: "memory");
        }
    }
    __syncthreads();
}

__device__ __forceinline__ void odd_prep(const KArgs& a, int j, const bf16_t* Z1, bf16_t* CQ, bf16_t* KV, bf16_t* KI, float* WI) {
    const int tid = opaque_tid(), lane = tid & 63, gw = blockIdx.x * 8 + (tid >> 6), nw = gridDim.x * 8;
    const int* pos = (const int*)a.in[2];
    const float* qn = (const float*)a.in[14] + (size_t)j * 512 + lane * 8; const float* kn = (const float*)a.in[15] + (size_t)j * 256 + lane * 4;
    const f32x4 qn0 = *(const f32x4*)qn, qn1 = *(const f32x4*)(qn + 4), kn0 = *(const f32x4*)kn;
    const float ikg = ((const float*)a.in[20])[j * 64 + lane], ikb = ((const float*)a.in[21])[j * 64 + lane];
    const float inv64 = exp2f(-(float)(lane & 31) * (13.287712379549449f * 2.0f / 64.0f)), inv32 = exp2f(-(float)(lane & 15) * (13.287712379549449f * 2.0f / 32.0f));
    for (int row = gw; row < M; row += nw) {
        const bf16_t* z = Z1 + (size_t)row * 1024; const float ps = (float)pos[row];
        {   const u32x4 x = *(const u32x4*)(z + lane * 8);
            float v[8] = {bflo(x.x), bfhi(x.x), bflo(x.y), bfhi(x.y), bflo(x.z), bfhi(x.z), bflo(x.w), bfhi(x.w)}; float q = 0.f;
#pragma unroll
            for (int i = 0; i < 8; ++i) q += v[i] * v[i];
            const float rs = rsqrtf(wave_sum(q) * (1.0f / 512.0f) + LN_EPS);
            u32x4 o; o.x = pk2(v[0] * rs * qn0[0], v[1] * rs * qn0[1]); o.y = pk2(v[2] * rs * qn0[2], v[3] * rs * qn0[3]); o.z = pk2(v[4] * rs * qn1[0], v[5] * rs * qn1[1]); o.w = pk2(v[6] * rs * qn1[2], v[7] * rs * qn1[3]);
            *(u32x4*)(CQ + (size_t)row * 512 + lane * 8) = o; }
        {   const u32x2 x = *(const u32x2*)(z + 512 + lane * 4);
            const float v0 = bflo(x.x), v1 = bfhi(x.x), v2 = bflo(x.y), v3 = bfhi(x.y);
            const float rs = rsqrtf(wave_sum(v0 * v0 + v1 * v1 + v2 * v2 + v3 * v3) * (1.0f / 256.0f) + LN_EPS);
            u32x2 o; o.x = pk2(v0 * rs * kn0[0], v1 * rs * kn0[1]); o.y = pk2(v2 * rs * kn0[2], v3 * rs * kn0[3]);
            *(u32x2*)(KV + (size_t)row * 320 + lane * 4) = o; }
        {   const float kr = bf2f(z[768 + lane]); const float other = __shfl_xor(kr, 32);
            float s, c; sincos_rev(ps * inv64, s, c);
            const float outv = lane < 32 ? (kr * c - other * s) : (other * s + kr * c);
            KV[(size_t)row * 320 + 256 + lane] = (bf16_t)f2bf(outv); }
        {   const float ik = bf2f(z[832 + lane]); const float mu = wave_sum(ik) * (1.0f / 64.0f); const float dlt = ik - mu;
            const float rs = rsqrtf(wave_sum(dlt * dlt) * (1.0f / 64.0f) + LN_EPS); const float kv = dlt * rs * ikg + ikb;
            const float other = __shfl_xor(kv, 16); float s, c; sincos_rev(ps * inv32, s, c);
            float outv = kv; if (lane < 16) outv = kv * c - other * s; else if (lane < 32) outv = other * s + kv * c;
            KI[(size_t)(row >> 4) * 1024 + (size_t)(((lane >> 5) * 4 + ((lane & 31) >> 3)) * 128 + (row & 15) * 8 + (lane & 7))] = (bf16_t)f2bf(outv); }
        if (lane < 8) WI[(size_t)row * 8 + lane] = bf2f(z[896 + lane]) * 0.044194173824159216f;
    }
}

template <bool DOSEL> __device__ __forceinline__ void indexer_unit(LAS uchar* lds, int b, int t0, const bf16_t* Q2_, const bf16_t* KI_, const float* WI_, unsigned short* IDX_) {
    GAS const bf16_t* Q2 = (GAS const bf16_t*)Q2_; GAS const bf16_t* KI = (GAS const bf16_t*)KI_; GAS const float* WI = (GAS const float*)WI_; GAS unsigned short* IDX = (GAS unsigned short*)IDX_;
    const int tid = opaque_tid(), lane = tid & 63, w = __builtin_amdgcn_readfirstlane(tid >> 6), c16 = lane & 15, hq = lane >> 4;
    LAS float* SC = (LAS float*)lds;
    bf16x8 af[4][2]; float wv[4][4];
#pragma unroll
    for (int rt = 0; rt < 4; ++rt) {
        const size_t rowA = (size_t)(b * T + t0 + 2 * rt + (c16 >> 3));
#pragma unroll
        for (int ks = 0; ks < 2; ++ks) af[rt][ks] = gldvg(Q2 + rowA * 3072 + 2560 + (c16 & 7) * 64 + 32 * ks + 8 * hq);
        const size_t rowC = (size_t)(b * T + t0 + 2 * rt + (hq >> 1));
        const f32x4 wf = *(GAS const f32x4*)(WI + rowC * 8 + 4 * (hq & 1));
#pragma unroll
        for (int r = 0; r < 4; ++r) wv[rt][r] = wf[r];
    }
    const int nkt = (t0 + 7) / 16 + 1;
    bf16x8 b0[4], b1[4];
#define IX_LOAD(G0) do { _Pragma("unroll") for (int u = 0; u < 4; ++u) { int kt = (G0) + u; if (kt > nkt - 1) kt = nkt - 1; GAS const bf16_t* kp = KI + (size_t)(b * (T / 16) + kt) * 1024 + hq * 128 + c16 * 8; b0[u] = gldvg(kp); b1[u] = gldvg(kp + 512); } } while (0)
    if (w * 4 < nkt) IX_LOAD(w * 4);
    for (int g0 = w * 4; g0 < nkt; g0 += 32) {
        bf16x8 c0[4], c1[4];
#pragma unroll
        for (int u = 0; u < 4; ++u) { c0[u] = b0[u]; c1[u] = b1[u]; }
        if (g0 + 32 < nkt) IX_LOAD(g0 + 32);
#pragma unroll
        for (int u = 0; u < 4; ++u) { const int kt = g0 + u;
            if (kt < nkt) {
#pragma unroll
                for (int rt = 0; rt < 4; ++rt) {
                    f32x4 acc = {0.f, 0.f, 0.f, 0.f}; acc = mfma16(af[rt][0], c0[u], acc); acc = mfma16(af[rt][1], c1[u], acc);
                    float part = wv[rt][0] * fmaxf(acc[0], 0.f) + wv[rt][1] * fmaxf(acc[1], 0.f) + wv[rt][2] * fmaxf(acc[2], 0.f) + wv[rt][3] * fmaxf(acc[3], 0.f);
                    part += __shfl_xor(part, 16);
                    if ((hq & 1) == 0) SC[(2 * rt + (hq >> 1)) * 4096 + 16 * kt + c16] = part;
                } } }
    }
#undef IX_LOAD
    WG_SYNC();
    if (DOSEL) {
        const int tq = t0 + w, n = tq + 1; GAS unsigned short* out = IDX + (size_t)(b * T + tq) * 256;
        if (n <= 256) {
#pragma unroll
            for (int i = 0; i < 4; ++i) { const int s = i * 64 + lane; out[s] = (unsigned short)(s < n ? s : 0xFFFF); }
        } else {
            const int ni = (n + 63) >> 6; unsigned key[64];
#pragma unroll
            for (int i = 0; i < 64; ++i) { const int s = i * 64 + lane; unsigned k = 0u;
                if (i < ni && s < n) { const float f = SC[w * 4096 + s] + 0.0f; const unsigned u = __float_as_uint(f); k = (u & 0x80000000u) ? ~u : (u | 0x80000000u); }
                key[i] = k; }
            LAS unsigned* hist = (LAS unsigned*)(lds + 131072 + w * 1024);
            unsigned prefix = 0u; int remaining = 256;
#pragma unroll 1
            for (int pass = 0; pass < 4; ++pass) {
                const int shift = 24 - 8 * pass;
#pragma unroll
                for (int z = 0; z < 4; ++z) hist[lane + 64 * z] = 0u;
                asm volatile("s_waitcnt lgkmcnt(0)" ::: "memory");
#pragma unroll
                for (int i = 0; i < 64; ++i) if (i < ni) { const unsigned k = key[i];
                    const bool in = (pass == 0) || (((k ^ prefix) >> (shift + 8)) == 0u);
                    if (in) __hip_atomic_fetch_add(hist + ((k >> shift) & 255u), 1u, __ATOMIC_RELAXED, __HIP_MEMORY_SCOPE_WORKGROUP); }
                asm volatile("s_waitcnt lgkmcnt(0)" ::: "memory");
                const u32x4 cc = *(const LAS u32x4*)(hist + 4 * lane);
                const int ls = (int)(cc.x + cc.y + cc.z + cc.w); int suf = ls;
#pragma unroll
                for (int o = 1; o < 64; o <<= 1) { const int t2 = __shfl_down(suf, o); if (lane + o < 64) suf += t2; }
                const int excl = suf - ls;
                const bool hit = (excl < remaining) && (remaining <= suf);
                int binsel = 0, above = excl;
                if (hit) { int acc = excl;
                    if (acc + (int)cc.w >= remaining) { binsel = 3; above = acc; }
                    else { acc += (int)cc.w; if (acc + (int)cc.z >= remaining) { binsel = 2; above = acc; }
                        else { acc += (int)cc.z; if (acc + (int)cc.y >= remaining) { binsel = 1; above = acc; } else { acc += (int)cc.y; binsel = 0; above = acc; } } } }
                const unsigned long long hb = __ballot(hit); const int src = __ffsll((long long)hb) - 1;
                const int bsel = __shfl(4 * lane + binsel, src), ab = __shfl(above, src);
                prefix |= ((unsigned)bsel) << shift; remaining -= ab;
                asm volatile("" ::: "memory");
            }
            const unsigned Tv = prefix;
            int neq = 0;
#pragma unroll
            for (int i = 0; i < 64; ++i) neq += (i < ni && key[i] == Tv) ? 1 : 0;
            int tot_eq = neq;
#pragma unroll
            for (int o = 32; o; o >>= 1) tot_eq += __shfl_xor(tot_eq, o);
            if (tot_eq == remaining) {
                int mine = 0;
#pragma unroll
                for (int i = 0; i < 64; ++i) mine += (i < ni && key[i] >= Tv) ? 1 : 0;
                int incl = mine;
#pragma unroll
                for (int o = 1; o < 64; o <<= 1) { const int t2 = __shfl_up(incl, o); if (lane >= o) incl += t2; }
                int my = incl - mine;
#pragma unroll
                for (int i = 0; i < 64; ++i) if (i < ni && key[i] >= Tv) { out[my] = (unsigned short)(i * 64 + lane); ++my; }
            } else {
                int pos = 0;
#pragma unroll
                for (int i = 0; i < 64; ++i) if (i < ni) { const bool pr = key[i] > Tv; const unsigned long long bal = __ballot(pr);
                    const int my = pos + (int)__builtin_amdgcn_mbcnt_hi((unsigned)(bal >> 32), __builtin_amdgcn_mbcnt_lo((unsigned)bal, 0u));
                    if (pr) out[my] = (unsigned short)(i * 64 + lane); pos += __popcll(bal); }
#pragma unroll
                for (int i = 0; i < 64; ++i) if (i < ni) { const bool pr = key[i] == Tv; const unsigned long long bal = __ballot(pr);
                    const int my = pos + (int)__builtin_amdgcn_mbcnt_hi((unsigned)(bal >> 32), __builtin_amdgcn_mbcnt_lo((unsigned)bal, 0u));
                    if (pr && my < 256) out[my] = (unsigned short)(i * 64 + lane); pos += __popcll(bal); }
            }
        }
    }
    WG_SYNC();
}

__device__ __forceinline__ void sparse_unit(LAS uchar* lds, int b, int t0, bf16_t* Q2_, const bf16_t* KV_, const unsigned short* IDX_, bool dry) {
    GAS bf16_t* Q2 = (GAS bf16_t*)Q2_; GAS const bf16_t* KV = (GAS const bf16_t*)KV_; GAS const unsigned short* IDX = (GAS const unsigned short*)IDX_;
    const int tid = opaque_tid(), lane = tid & 63, w = __builtin_amdgcn_readfirstlane(tid >> 6), c16 = lane & 15, hq = lane >> 4;
    LAS uchar* VL = lds + w * 17408;
    LAS unsigned short* IDL = (LAS unsigned short*)(lds + 139264 + w * 512);
    const int tq = t0 + w; const size_t row = (size_t)(b * T + tq);
    *(LAS u32x2*)(IDL + lane * 4) = *(GAS const u32x2*)(IDX + row * 256 + lane * 4);
    bf16x8 qf[10];
#pragma unroll
    for (int ks = 0; ks < 10; ++ks) { u32x4 z = {0u, 0u, 0u, 0u};
        if (c16 < 8) z = *(GAS const u32x4*)(Q2 + row * 3072 + (ks < 8 ? c16 * 256 + 32 * ks : 2048 + c16 * 64 + 32 * (ks - 8)) + 8 * hq);
        qf[ks] = __builtin_bit_cast(bf16x8, z); }
    float mr = NEGF, lr = 0.f; f32x4 o[16];
#pragma unroll
    for (int ct = 0; ct < 16; ++ct) o[ct] = (f32x4){0.f, 0.f, 0.f, 0.f};
    asm volatile("s_waitcnt lgkmcnt(0)" ::: "memory");
    u32x4 g[16]; bf16x8 kr0[2], kr1[2];
#define SP_ISSUE(CH) do { _Pragma("unroll") for (int it = 0; it < 16; ++it) { int id = (int)IDL[(CH) * 32 + it * 2 + (lane >> 5)]; if (id > tq) id = 0; \
            g[it] = *(GAS const u32x4*)(KV + (size_t)(b * T + id) * 320 + (lane & 31) * 8); } \
        _Pragma("unroll") for (int kt = 0; kt < 2; ++kt) { int idk = (int)IDL[(CH) * 32 + 16 * kt + c16]; if (idk > tq) idk = 0; \
            GAS const bf16_t* kr = KV + (size_t)(b * T + idk) * 320 + 256 + 8 * hq; kr0[kt] = gldvg(kr); kr1[kt] = gldvg(kr + 32); } } while (0)
    SP_ISSUE(0);
#pragma unroll 1
    for (int ch = 0; ch < 8; ++ch) {
#pragma unroll
        for (int it = 0; it < 16; ++it) *(LAS u32x4*)(VL + (it * 2 + (lane >> 5)) * 544 + (lane & 31) * 16) = g[it];
        const bf16x8 r00 = kr0[0], r01 = kr0[1], r10 = kr1[0], r11 = kr1[1];
        asm volatile("s_waitcnt lgkmcnt(0)" ::: "memory");
        if (ch < 7) SP_ISSUE(ch + 1);
        f32x4 s[2];
#pragma unroll
        for (int kt = 0; kt < 2; ++kt) {
            f32x4 acc = {0.f, 0.f, 0.f, 0.f};
#pragma unroll
            for (int ks = 0; ks < 8; ++ks) acc = mfma16(ldsv(VL + (16 * kt + c16) * 544 + (32 * ks + 8 * hq) * 2), qf[ks], acc);
            acc = mfma16(kt ? r01 : r00, qf[8], acc); acc = mfma16(kt ? r11 : r10, qf[9], acc);
            s[kt] = acc;
        }
        unsigned vm = 0u; float mx = NEGF;
#pragma unroll
        for (int kt = 0; kt < 2; ++kt) { const u32x2 idw = *(const LAS u32x2*)(IDL + ch * 32 + 16 * kt + 4 * hq);
            const int id4[4] = {(int)(idw.x & 0xffff), (int)(idw.x >> 16), (int)(idw.y & 0xffff), (int)(idw.y >> 16)};
#pragma unroll
            for (int r = 0; r < 4; ++r) if (id4[r] <= tq) { vm |= 1u << (kt * 4 + r); mx = fmaxf(mx, s[kt][r]); } }
        mx = fmaxf(mx, __shfl_xor(mx, 16)); mx = fmaxf(mx, __shfl_xor(mx, 32));
        const float mnew = fmaxf(mr, mx), alpha = __expf(mr - mnew); float sum = 0.f;
#pragma unroll
        for (int kt = 0; kt < 2; ++kt)
#pragma unroll
            for (int r = 0; r < 4; ++r) { const float p = ((vm >> (kt * 4 + r)) & 1u) ? __expf(s[kt][r] - mnew) : 0.f; s[kt][r] = p; sum += p; }
        sum += __shfl_xor(sum, 16); sum += __shfl_xor(sum, 32);
        lr = lr * alpha + sum; mr = mnew;
        const bf16x8 B = pack8(s[0], s[1]);
#pragma unroll
        for (int ct = 0; ct < 16; ++ct) {
            const s16x4 lo = tr16(VL + (4 * hq + (c16 >> 2)) * 544 + (16 * ct + 4 * (c16 & 3)) * 2), hi = tr16(VL + (16 + 4 * hq + (c16 >> 2)) * 544 + (16 * ct + 4 * (c16 & 3)) * 2);
            o[ct] = mfma16(cat4(lo, hi), B, o[ct] * alpha);
        }
        asm volatile("s_waitcnt lgkmcnt(0)" ::: "memory");
    }
#undef SP_ISSUE
    float inv = lr > 0.f ? 1.0f / lr : 0.f;
#ifdef PROBE_DSA_SCALE
    inv *= (float)(PROBE_DSA_SCALE);
#endif
    if (c16 < 8 && !dry) {
#pragma unroll
        for (int ct = 0; ct < 16; ++ct) { u32x2 wv; wv.x = pk2(o[ct][0] * inv, o[ct][1] * inv); wv.y = pk2(o[ct][2] * inv, o[ct][3] * inv);
            *(GAS u32x2*)(Q2 + row * 3072 + c16 * 256 + 16 * ct + 4 * hq) = wv; }
    }
}

__global__ void __launch_bounds__(NTHR, 2) fwd_kernel(KArgs a) {
    extern __shared__ __attribute__((aligned(16))) uchar lds_raw[];
    LAS uchar* lds = (LAS uchar*)lds_raw;
    cg::grid_group grid = cg::this_grid();
    volatile LAS unsigned* xst = (volatile LAS unsigned*)(lds + LDS_BYTES - 16);
    if (threadIdx.x < 4) xst[threadIdx.x] = 0u;
    __syncthreads();
    if (blockIdx.x == 0) { unsigned* bw = (unsigned*)(a.ws + WS_MISC); for (int i = threadIdx.x; i < 4096; i += NTHR) __hip_atomic_store(bw + i, 0u, __ATOMIC_RELAXED, __HIP_MEMORY_SCOPE_AGENT); }
    XcdBarrier xb; xb.bar = (unsigned*)(a.ws + WS_MISC); xb.x = 0; xb.st = xst;
    for (int ph = a.ph_lo; ph < a.ph_hi; ++ph) {
        uchar* ws = a.ws; asm volatile("" : "+s"(ws));
        bf16_t* HB = (bf16_t*)(ws + WS_HB); bf16_t* R1 = (bf16_t*)(ws + WS_R1); bf16_t* R2 = (bf16_t*)(ws + WS_R2);
        float* H = a.out; asm volatile("" : "+s"(H));
        const int G = gridDim.x, bid = blockIdx.x;
        int L = 0, op = 19;
        if (ph > 0) { const int pp = ph - 1, pair = pp / 25, r = pp % 25;
            if (r < 12) { L = 2 * pair; op = r < 5 ? r : 12 + (r - 5); } else { const int r2 = r - 12; L = 2 * pair + 1; op = r2 < 6 ? 6 + r2 : 12 + (r2 - 6); } }
        const int j = L >> 1;
        const bf16_t* sl = (const bf16_t*)(ws + WS_WB) + (size_t)L * (WSLOT / 2);
        bf16_t* Z = R1; bf16_t* KC = R1 + (size_t)M * ZE; bf16_t* VC = KC + 8 * 2 * 256 * 64; bf16_t* Y = R2;
        bf16_t* Z1 = R1; bf16_t* Q2 = R1 + (size_t)M * 1024; unsigned short* IDX = (unsigned short*)R1;
        bf16_t* CQ = R2; bf16_t* KV = R2 + (size_t)M * 512; bf16_t* KI = KV + (size_t)M * 320; float* WI = (float*)(KI + (size_t)M * 64);
        bf16_t* U = R1; bf16_t* Pb = R1 + (size_t)16384 * 4096; bf16_t* PE = R2;
#ifndef PROBE_DUP
#define PROBE_DUP 0
#endif
#define MK_MLBUF float* mls = (float*)(ws + WS_MISC + 65536); const MlBuf mb{HB, mls, mls + 32 * 64 * 128, mls + 32 * 64 * 128 + 2048, mls + 32 * 64 * 128 + 4096}
        const int nrep = ((PROBE_DUP >> op) & 1) ? 2 : 1;
        for (int rep = 0; rep < nrep; ++rep) {
        switch (op) {
        case 19: prologue(a, lds); break;
        case 0: run_gemm(lds, L == 0 ? HB : R2, D, sl + OA, M, ZE, D, FStoreBf16{Z, ZE, 0}); break;
        case 1: { MK_MLBUF;
            for (int u = bid; u < 512; u += G) compress_unit(a, j, lds, u, Z, sl, KC, VC);
            for (int u = bid; u < 2048; u += G) mlstmA_unit(a, j, lds, u, Z, mb);
            break; }
        case 2: { MK_MLBUF; mlstm_scan(mb); break; }
        case 3: { MK_MLBUF;
            for (int u = bid; u < 1024; u += G) { const int i = u >> 8, wg = u & 255, bg = wg & 15, base = wg >> 4; const int qb = i == 0 ? 63 - base : (i == 1 ? 32 + base : (i == 2 ? 31 - base : base));
                nsa_unit(a, j, lds, bg >> 1, bg & 1, qb, Z, KC, VC, Y); }
            for (int u = bid; u < 2048; u += G) mlstmC_unit(a, j, lds, u, Z, Y, mb);
            break; }
        case 4: run_gemm(lds, Y, D, sl + OWOUT, M, D, D, FResid{L == 0 ? (const float*)a.in[0] : H, H, DN_ALPHA}); break;
        case 6: run_gemm(lds, R2, D, sl + OA, M, 1024, D, FStoreBf16{Z1, 1024, 0}); break;
        case 7: odd_prep(a, j, Z1, CQ, KV, KI, WI); break;
        case 8: run_gemm(lds, CQ, 512, sl + OWQ, M, 3072, 512, FQ2{Q2, (const int*)a.in[2]}); break;
        case 9:
            if (G == 256) {
                const int bb = bid & 7, li = bid >> 3;
                for (int i = 0; i < 16; ++i) { const int x = li + 32 * (i >> 1); indexer_unit<true>(lds, bb, ((i & 1) ? 511 - x : x) * 8, Q2, KI, WI, IDX); } }
            else { for (int u = bid; u < 4096; u += G) { const int uu = 4095 - u; indexer_unit<true>(lds, uu >> 9, (uu & 511) * 8, Q2, KI, WI, IDX); } }
            break;
        case 10:
            if (G == 256) { const int bb = bid & 7, li = bid >> 3;
                for (int i = 0; i < 16; ++i) sparse_unit(lds, bb, (li + 32 * i) * 8, Q2, KV, IDX, rep + 1 < nrep); }
            else { for (int u = bid; u < 4096; u += G) sparse_unit(lds, u >> 9, (u & 511) * 8, Q2, KV, IDX, rep + 1 < nrep); }
            WG_SYNC(); break;
        case 11: run_gemm(lds, Q2, 3072, sl + OWF, M, D, 2048, FResid{H, H, DN_ALPHA}); break;
        case 12: ln_pass(H, (const float*)a.in[23] + L * D, (const float*)a.in[24] + L * D, HB, (const float*)a.in[1] + (size_t)L * M * 256, Pb, (float*)(ws + WS_MISC + 4 * MiB)); break;
        case 13: run_gemm(lds, HB, D, sl + OW1, 16384, 4096, D, FStoreBf16{U, 4096, 1}); break;
        case 14: if (rep == 0) run_gemm(lds, U, 4096, sl + OW2, 16384, D, 4096, FResidLn{H, (const float*)(ws + WS_MISC + 4 * MiB), (const float*)a.in[23] + L * D, (const float*)a.in[24] + L * D});
                 run_gemm(lds, Pb, 256, sl + OWP, M, D, 256, FStoreBf16{PE, D, 0}); break;
        case 15: run_gemm(lds, HB + (size_t)16384 * D, D, sl + OW1, 16384, 4096, D, FStoreBf16{U, 4096, 1}); break;
        case 16: run_gemm(lds, U, 4096, sl + OW2, 16384, D, 4096, FResidLn{H + (size_t)16384 * D, (const float*)(ws + WS_MISC + 4 * MiB) + 2 * 16384, (const float*)a.in[23] + L * D, (const float*)a.in[24] + L * D}); break;
        case 17: ln_pass(H, (const float*)a.in[25] + L * D, (const float*)a.in[26] + L * D, HB, nullptr, nullptr, (float*)(ws + WS_MISC + 5 * MiB)); break;
        case 18: run_gemm(lds, HB, D, sl + OWG, M, D, D, FGateLn{H, PE, PE, (const float*)(ws + WS_MISC + 5 * MiB), (const float*)a.in[25] + L * D, (const float*)a.in[26] + L * D}); break;
        default: break;
        }
        if (rep + 1 < nrep) { __threadfence(); WG_SYNC(); }
        }
        if (ph + 1 < a.ph_hi) { if (ph == a.ph_lo) { grid.sync(); xb = xcd_barrier_post((unsigned*)(a.ws + WS_MISC), xst); } else xcd_barrier(xb); }
#ifdef PROBE_SYNCS
        if (ph == 5) { for (int z = 0; z < PROBE_SYNCS; ++z) grid.sync(); }
#endif
    }
}
constexpr int N_PHASES = 1 + 2 * 25;

extern "C" void kernel_launch(void* const* d_in, const int* in_sizes, int n_in, void* d_out, int out_size, void* d_ws, size_t ws_size, hipStream_t stream) {
    static int grid = 0;
    if (grid == 0) {
        if (n_in != 31 || out_size != M * D || ws_size < WS_NEED) { fprintf(stderr, "kernel_launch: unexpected problem (n_in %d out %d ws %zu)\n", n_in, out_size, ws_size); grid = -1; return; }
        int dev = 0, cus = 0, per_cu = 0;
        hipGetDevice(&dev); hipDeviceGetAttribute(&cus, hipDeviceAttributeMultiprocessorCount, dev);
        if (hipFuncSetAttribute((const void*)fwd_kernel, hipFuncAttributeMaxDynamicSharedMemorySize, LDS_BYTES) != hipSuccess) { fprintf(stderr, "kernel_launch: hipFuncSetAttribute failed\n"); grid = -1; return; }
        if (hipOccupancyMaxActiveBlocksPerMultiprocessor(&per_cu, (const void*)fwd_kernel, NTHR, LDS_BYTES) != hipSuccess || per_cu < 1) { fprintf(stderr, "kernel_launch: occupancy query gave %d\n", per_cu); per_cu = 1; }
        (void)hipGetLastError();
        grid = cus * 1;
        fprintf(stderr, "kernel_launch: grid %d (cus %d, per_cu %d)\n", grid, cus, per_cu);
    }
    if (grid < 0) return;
    KArgs a{};
    for (int i = 0; i < 31; ++i) a.in[i] = d_in[i];
    a.out = (float*)d_out; a.ws = (uchar*)d_ws;
#ifndef MK_MULTI
    a.ph_lo = 0; a.ph_hi = N_PHASES;
    void* args[] = {&a};
    hipError_t e = hipLaunchCooperativeKernel((const void*)fwd_kernel, dim3(grid), dim3(NTHR), args, LDS_BYTES, stream);
    if (e != hipSuccess) fprintf(stderr, "cooperative launch failed: %s (grid %d)\n", hipGetErrorString(e), grid);
#else
    for (int p = 0; p < N_PHASES; ++p) { a.ph_lo = p; a.ph_hi = p + 1; hipLaunchKernelGGL(fwd_kernel, dim3(grid), dim3(NTHR), LDS_BYTES, stream, a); }
#endif
}
```
